# Optimizing an MI355X kernel written in HIP

```python
import jax, jax.numpy as jnp
from jax import lax
import numpy as np

D_MODEL = 4096
BATCH = 2
SEQ = 4096
DEPTH = 2

HEAD_DIM = 128
BRANCH_WIDTH = D_MODEL // 2
N_HEADS_A = BRANCH_WIDTH // HEAD_DIM
N_HEADS_C = BRANCH_WIDTH // HEAD_DIM
MOBA_BLOCK = 256
MOBA_TOPK = 3
Q_BLOCK = 128
ROPE_THETA = 500000.0
ROPE_DIM = HEAD_DIM // 4
CONV_WIDTH = 3
N_BRANCHES = 3
RMS_EPS = 1e-6
IN_COLS = 12 * BRANCH_WIDTH + N_BRANCHES * D_MODEL

kernel_name = 'hybrid_moba_shortconv_stickbreaking'


def rms_norm(x, g):
    xf = x.astype(jnp.float32)
    y = xf * lax.rsqrt(jnp.mean(xf * xf, axis=-1, keepdims=True) + RMS_EPS)
    return (y * g.astype(jnp.float32)).astype(x.dtype)


def split_heads(t, n_heads):
    b, s, _ = t.shape
    return t.reshape(b, s, n_heads, HEAD_DIM).transpose(0, 2, 1, 3)


def merge_heads(t):
    b, h, s, d = t.shape
    return t.transpose(0, 2, 1, 3).reshape(b, s, h * d)


def partial_rope(x, pos):
    half = ROPE_DIM // 2
    inv_freq = ROPE_THETA ** (-jnp.arange(half, dtype=jnp.float32) / half)
    ang = pos.astype(jnp.float32)[:, None] * inv_freq[None, :]
    cos = jnp.cos(ang).astype(x.dtype)
    sin = jnp.sin(ang).astype(x.dtype)
    x1 = x[..., :half]
    x2 = x[..., half:ROPE_DIM]
    rest = x[..., ROPE_DIM:]
    return jnp.concatenate([x1 * cos - x2 * sin, x2 * cos + x1 * sin, rest], axis=-1)


def moba_attention(q, k, v):
    b, h, s, d = q.shape
    n_blk = -(-s // MOBA_BLOCK)
    s_pad = n_blk * MOBA_BLOCK
    pad = ((0, 0), (0, 0), (0, s_pad - s), (0, 0))
    q = jnp.pad(q, pad)
    k = jnp.pad(k, pad)
    v = jnp.pad(v, pad)
    scale = d ** -0.5
    qf = q.reshape(b * h, s_pad, d)
    kb = k.reshape(b * h, n_blk, MOBA_BLOCK, d)
    vb = v.reshape(b * h, n_blk, MOBA_BLOCK, d)
    k_mean = jnp.mean(kb.astype(jnp.float32), axis=2)
    gate = jnp.einsum('nsd,nbd->nsb', qf.astype(jnp.float32), k_mean)
    q_blk = jnp.arange(s_pad) // MOBA_BLOCK
    past = jnp.arange(n_blk)[None, :] < q_blk[:, None]
    gate = jnp.where(past[None], gate, -jnp.inf)
    n_sel = min(MOBA_TOPK, n_blk)
    _, sel = lax.top_k(gate, n_sel)
    sel_ok = sel < q_blk[None, :, None]
    n_chunks = s_pad // Q_BLOCK
    bh_ids = jnp.repeat(jnp.arange(b * h), n_chunks)
    c_ids = jnp.tile(jnp.arange(n_chunks), b * h)

    def one_chunk(ids):
        bh, c = ids
        start = c * Q_BLOCK
        qc = lax.dynamic_slice_in_dim(qf[bh], start, Q_BLOCK, 0)
        idx = lax.dynamic_slice_in_dim(sel[bh], start, Q_BLOCK, 0)
        ok = lax.dynamic_slice_in_dim(sel_ok[bh], start, Q_BLOCK, 0)
        k_sel = kb[bh, idx]
        v_sel = vb[bh, idx]
        own = start // MOBA_BLOCK
        k_own = kb[bh, own]
        v_own = vb[bh, own]
        s_sel = jnp.einsum('qd,qnkd->qnk', qc, k_sel).astype(jnp.float32) * scale
        s_sel = jnp.where(ok[:, :, None], s_sel, -jnp.inf).reshape(Q_BLOCK, n_sel * MOBA_BLOCK)
        q_pos = start + jnp.arange(Q_BLOCK)
        k_pos = own * MOBA_BLOCK + jnp.arange(MOBA_BLOCK)
        s_own = jnp.einsum('qd,kd->qk', qc, k_own).astype(jnp.float32) * scale
        s_own = jnp.where(k_pos[None, :] <= q_pos[:, None], s_own, -jnp.inf)
        p = jax.nn.softmax(jnp.concatenate([s_sel, s_own], axis=-1), axis=-1).astype(v.dtype)
        p_sel = p[:, :n_sel * MOBA_BLOCK].reshape(Q_BLOCK, n_sel, MOBA_BLOCK)
        p_own = p[:, n_sel * MOBA_BLOCK:]
        return jnp.einsum('qnk,qnkd->qd', p_sel, v_sel) + jnp.einsum('qk,kd->qd', p_own, v_own)

    out = lax.map(one_chunk, (bh_ids, c_ids))
    return out.reshape(b, h, s_pad, d)[:, :, :s]


def stick_breaking_attention(q, k, v):
    b, h, s, d = q.shape
    n_blocks = s // Q_BLOCK
    scale = d ** -0.5
    k_pos = jnp.arange(s)
    qb = q.reshape(b, h, n_blocks, Q_BLOCK, d).transpose(2, 0, 1, 3, 4)

    def one_block(args):
        q_blk, i = args
        z = jnp.einsum('bhqd,bhkd->bhqk', q_blk, k).astype(jnp.float32) * scale
        q_pos = i * Q_BLOCK + jnp.arange(Q_BLOCK)
        causal = k_pos[None, :] < q_pos[:, None]
        log_keep = jnp.where(causal, jax.nn.log_sigmoid(-z), 0.0)
        later = lax.cumsum(log_keep, axis=log_keep.ndim - 1, reverse=True) - log_keep
        a = jnp.where(causal, jnp.exp(jax.nn.log_sigmoid(z) + later), 0.0).astype(v.dtype)
        return jnp.einsum('bhqk,bhkd->bhqd', a, v)

    out = lax.map(one_block, (qb, jnp.arange(n_blocks)))
    return out.transpose(1, 2, 0, 3, 4).reshape(b, h, s, d)


def short_conv_mixer(b_gate, c_gate, u, conv_w):
    xc = c_gate * u
    w = xc.shape[-1]
    y = lax.conv_general_dilated(
        xc, conv_w[:, None, :].astype(xc.dtype), window_strides=(1,),
        padding=[(CONV_WIDTH - 1, 0)], dimension_numbers=('NWC', 'WIO', 'NWC'),
        feature_group_count=w)
    return b_gate * y


def hybrid_layer(x, pre_g, post_g, w_in, b_merge, conv_w, p_a, p_b, p_c, w_o):
    b, s, _ = x.shape
    h = rms_norm(x, pre_g)
    proj = jnp.einsum('bsd,dc->bsc', h, w_in)
    cuts = [BRANCH_WIDTH * i for i in range(1, 13)]
    (aq, ak, av, az, bb, bc, bx, bz, cq, ck, cv, cz, g) = jnp.split(proj, cuts, axis=-1)
    pos = jnp.arange(s)
    qa = partial_rope(split_heads(aq, N_HEADS_A), pos)
    ka = partial_rope(split_heads(ak, N_HEADS_A), pos)
    o_a = merge_heads(moba_attention(qa, ka, split_heads(av, N_HEADS_A))) * jax.nn.silu(az)
    o_b = short_conv_mixer(bb, bc, bx, conv_w) * jax.nn.silu(bz)
    o_c = merge_heads(stick_breaking_attention(
        split_heads(cq, N_HEADS_C), split_heads(ck, N_HEADS_C), split_heads(cv, N_HEADS_C))) * jax.nn.silu(cz)
    gates = jax.nn.sigmoid((g + b_merge).reshape(b, s, N_BRANCHES, D_MODEL))
    y = (gates[:, :, 0] * jnp.einsum('bsw,wd->bsd', o_a, p_a)
         + gates[:, :, 1] * jnp.einsum('bsw,wd->bsd', o_b, p_b)
         + gates[:, :, 2] * jnp.einsum('bsw,wd->bsd', o_c, p_c))
    out = jnp.einsum('bsd,de->bse', y, w_o)
    return x + rms_norm(out, post_g)


def setup_inputs(seed: int = 0) -> dict:
    key = jax.random.key(seed)
    ks = jax.random.split(key, 10)
    f32 = jnp.float32
    x = jax.random.normal(ks[0], (BATCH, SEQ, D_MODEL), f32)
    pre_norm_gain = 1.0 + 0.05 * jax.random.normal(ks[1], (DEPTH, D_MODEL), f32)
    post_norm_gain = 1.0 + 0.05 * jax.random.normal(ks[2], (DEPTH, D_MODEL), f32)
    w_in = jax.random.normal(ks[3], (DEPTH, D_MODEL, IN_COLS), f32) * D_MODEL ** -0.5
    b_merge_gate = 0.01 * jax.random.normal(ks[4], (DEPTH, N_BRANCHES * D_MODEL), f32)
    conv_w = jax.random.normal(ks[5], (DEPTH, CONV_WIDTH, BRANCH_WIDTH), f32) * CONV_WIDTH ** -0.5
    w_branch_a = jax.random.normal(ks[6], (DEPTH, BRANCH_WIDTH, D_MODEL), f32) * BRANCH_WIDTH ** -0.5
    w_branch_b = jax.random.normal(ks[7], (DEPTH, BRANCH_WIDTH, D_MODEL), f32) * BRANCH_WIDTH ** -0.5
    w_branch_c = jax.random.normal(ks[8], (DEPTH, BRANCH_WIDTH, D_MODEL), f32) * BRANCH_WIDTH ** -0.5
    w_out = jax.random.normal(ks[9], (DEPTH, D_MODEL, D_MODEL), f32) * D_MODEL ** -0.5
    return {'x': x, 'pre_norm_gain': pre_norm_gain, 'post_norm_gain': post_norm_gain,
            'w_in': w_in, 'b_merge_gate': b_merge_gate, 'conv_w': conv_w,
            'w_branch_a': w_branch_a, 'w_branch_b': w_branch_b, 'w_branch_c': w_branch_c,
            'w_out': w_out}


def reference(x, pre_norm_gain, post_norm_gain, w_in, b_merge_gate, conv_w,
              w_branch_a, w_branch_b, w_branch_c, w_out):
    for layer in range(DEPTH):
        x = hybrid_layer(x, pre_norm_gain[layer], post_norm_gain[layer], w_in[layer],
                         b_merge_gate[layer], conv_w[layer], w_branch_a[layer],
                         w_branch_b[layer], w_branch_c[layer], w_out[layer])
    return x
```

```cpp
#include <hip/hip_runtime.h>
#include <cstdio>
#include <cstdint>
namespace pg8 {
#define PG8_LAS __attribute__((address_space(3)))
typedef unsigned short bf16_t;
typedef short bf16x8 __attribute__((ext_vector_type(8)));
typedef float f32x4 __attribute__((ext_vector_type(4)));
typedef unsigned u32x4 __attribute__((ext_vector_type(4)));
constexpr int BM = 256, BK = 64, HALF = 128, HTB = HALF * BK * 2  , STAGE_BYTES = 8 * HTB, NXCD = 8, WGM = 8;

__host__ __device__ __forceinline__ int lds_byte(int r, int c) { const int st = (r >> 4) * 2 + (c >> 5), rr = r & 15, cc = c & 31, ob = rr * 64 + cc * 2; return st * 1024 + (ob ^ (((ob >> 9) & 1) << 5)); }
__host__ __device__ __forceinline__ void stage_rc(int b, int& R, int& C) { const int st = b / 1024, sb = b % 1024, swz = sb ^ (((sb >> 9) & 1) << 5); R = (st >> 1) * 16 + swz / 64; C = (st & 1) * 32 + (swz % 64) / 2; }
__host__ __device__ __forceinline__ int perm32(int rho) { const int n = rho >> 4, i = rho & 15; return 8 * (i >> 2) + 4 * n + (i & 3); }

struct Unit { int pm, pn; };
struct Gemm { const bf16_t* A; const bf16_t* Bt; int M, N, K, pad; };

struct StaticOrder {
    int nM, nN, nwg, G, c;
    __host__ __device__ void init(int M, int N, int G_, int c_) { nM = M / BM; nN = N / BM; nwg = nM * nN; G = G_; c = c_; }
    __host__ __device__ bool next(int i, Unit& u) const {
        const long L = (long)i * G + c; if (L >= nwg) return false;
        int wgid = (int)L; { const int q = nwg / NXCD, r = nwg % NXCD, xcd = wgid % NXCD, off = wgid / NXCD; wgid = (xcd < r ? xcd * (q + 1) : r * (q + 1) + (xcd - r) * q) + off; }
        const int nig = WGM * nN, gid = wgid / nig, fm = gid * WGM, gsz = (nM - fm) < WGM ? (nM - fm) : WGM;
        u.pm = fm + ((wgid % nig) % gsz); u.pn = (wgid % nig) / gsz; return true;
    }
    __device__ __forceinline__ void a_ready(const Unit&) const {}
    __device__ __forceinline__ void done(const Unit&) const {}
};

__device__ __forceinline__ unsigned cvt_pk_bf16(float lo, float hi) { unsigned r; asm volatile("v_cvt_pk_bf16_f32 %0, %1, %2" : "=v"(r) : "v"(lo), "v"(hi)); return r; }
typedef float f32x2 __attribute__((ext_vector_type(2)));
struct EpiBf16 {
    static constexpr bool PERM = true, AFTER_DRAIN = false;
    bf16_t* O; int ldc; int split_cols; size_t split_stride;
    __device__ __forceinline__ void operator()(const f32x4 (&acc)[2][2][4][2], const Unit& u, int wr, int wc, int fr, int fq) const {
        const int row0 = u.pm * BM + wr * 64 + fr; int colt = u.pn * BM; bf16_t* base = O;
        if (split_cols) { const int t = colt / split_cols; base += (size_t)t * split_stride; colt -= t * split_cols; }
        const int col0 = colt + wc * 32 + 8 * fq;
#pragma unroll
        for (int ai = 0; ai < 2; ++ai)
#pragma unroll
            for (int m = 0; m < 4; ++m) { bf16_t* rowp = base + (size_t)(row0 + ai * HALF + m * 16) * ldc + col0;
#pragma unroll
                for (int bj = 0; bj < 2; ++bj) { const f32x4 v0 = acc[ai][bj][m][0], v1 = acc[ai][bj][m][1];
                    u32x4 w; w.x = cvt_pk_bf16(v0[0], v0[1]); w.y = cvt_pk_bf16(v0[2], v0[3]); w.z = cvt_pk_bf16(v1[0], v1[1]); w.w = cvt_pk_bf16(v1[2], v1[3]);
                    *(u32x4*)(rowp + bj * HALF) = w; } }
    }
};
struct EpiF32 {
    static constexpr bool PERM = false, AFTER_DRAIN = false;
    float* C; const float* bias; int ldc, pad;
    __device__ __forceinline__ void operator()(const f32x4 (&acc)[2][2][4][2], const Unit& u, int wr, int wc, int fr, int fq) const {
        const int row0 = u.pm * BM + wr * 64 + fr, col0 = u.pn * BM + wc * 32 + 4 * fq;
        f32x4 bv[2][2];
#pragma unroll
        for (int bj = 0; bj < 2; ++bj)
#pragma unroll
            for (int n = 0; n < 2; ++n) bv[bj][n] = bias ? *(const f32x4*)(bias + col0 + bj * HALF + n * 16) : (f32x4){0.f, 0.f, 0.f, 0.f};
#pragma unroll
        for (int ai = 0; ai < 2; ++ai)
#pragma unroll
            for (int m = 0; m < 4; ++m) { float* rowp = C + (size_t)(row0 + ai * HALF + m * 16) * ldc + col0;
#pragma unroll
                for (int bj = 0; bj < 2; ++bj)
#pragma unroll
                    for (int n = 0; n < 2; ++n) *(f32x4*)(rowp + bj * HALF + n * 16) = acc[ai][bj][m][n] + bv[bj][n]; }
    }
};
template <class Epi, class Sched, bool ALIGN_EPI = false, bool SP2 = false>
__device__ __forceinline__ void gemm_phase(PG8_LAS unsigned char* lds, const Gemm g, const Sched& S, const Epi& E) {
    const int tid = threadIdx.x, wid = __builtin_amdgcn_readfirstlane(tid >> 6), lane = tid & 63, wr = wid >> 2, wc = wid & 3, fr = lane & 15, fq = lane >> 4;
    const int K = g.K, nt = K / BK;
    unsigned voffA[2], voffB[2];
#pragma unroll
    for (int i = 0; i < 2; ++i) { int R, C; stage_rc(tid * 16 + i * 8192, R, C); const int Rb = Epi::PERM ? ((R & ~31) + perm32(R & 31)) : R;
        voffA[i] = (unsigned)(R * K + C) * 2u; voffB[i] = (unsigned)(Rb * K + C) * 2u; }
    const size_t kstep = (size_t)(BK * 2);
    const size_t hstep = (size_t)HALF * K * 2;
    const size_t tstep = 2 * hstep;
    const unsigned ldsw = (unsigned)wid * 1024u;
    const int aoff = lds_byte(wr * 64 + fr, fq * 8), boff = lds_byte(wc * 32 + fr, fq * 8);
#define PG8_SA(b, h) (((b) * 2 + (h)) * HTB)
#define PG8_SB(b, h) ((4 + (b) * 2 + (h)) * HTB)
#define PG8_STAGE(bufoff, gbase, voff) do { _Pragma("unroll") for (int _i = 0; _i < 2; ++_i) \
        __builtin_amdgcn_global_load_lds((const unsigned*)((const char*)(gbase) + (voff)[_i]), (PG8_LAS unsigned*)(lds + (bufoff) + ldsw + _i * 8192), 16, 0, 0); } while (0)
#define PG8_LDA(dst, b, h) do { _Pragma("unroll") for (int m = 0; m < 4; ++m) _Pragma("unroll") for (int k = 0; k < 2; ++k) dst[m][k] = *(const PG8_LAS bf16x8*)(lds + PG8_SA(b, h) + aoff + m * 2048 + k * 1024); } while (0)
#define PG8_LDB(dst, b, h) do { _Pragma("unroll") for (int n = 0; n < 2; ++n) _Pragma("unroll") for (int k = 0; k < 2; ++k) dst[n][k] = *(const PG8_LAS bf16x8*)(lds + PG8_SB(b, h) + boff + n * 2048 + k * 1024); } while (0)
#define PG8_MMA(ai, bj, At, Bt) do { __builtin_amdgcn_s_setprio(1); _Pragma("unroll") for (int m = 0; m < 4; ++m) _Pragma("unroll") for (int n = 0; n < 2; ++n) _Pragma("unroll") for (int k = 0; k < 2; ++k) \
        acc[ai][bj][m][n] = __builtin_amdgcn_mfma_f32_16x16x32_bf16(Bt[n][k], At[m][k], acc[ai][bj][m][n], 0, 0, 0); __builtin_amdgcn_s_setprio(0); } while (0)
#define PG8_WAIT_V(n) asm volatile("s_waitcnt vmcnt(" #n ")" ::: "memory")
#define PG8_WAIT_L(n) asm volatile("s_waitcnt lgkmcnt(" #n ")" ::: "memory")
#define PG8_BAR __builtin_amdgcn_s_barrier()
#define PG8_SCHED __builtin_amdgcn_sched_barrier(0)
    Unit cur, nxt; int ui = 0;
    if (!S.next(0, cur)) return;
    f32x4 acc[2][2][4][2];
#pragma unroll
    for (int a = 0; a < 2; ++a)
#pragma unroll
        for (int b = 0; b < 2; ++b)
#pragma unroll
            for (int m = 0; m < 4; ++m)
#pragma unroll
                for (int n = 0; n < 2; ++n) acc[a][b][m][n] = (f32x4){0.f, 0.f, 0.f, 0.f};
    bf16x8 At[4][2], B0[2][2], B1[2][2];
    const char* cA = (const char*)g.A + (size_t)cur.pm * tstep; const char* cB = (const char*)g.Bt + (size_t)cur.pn * tstep;
    S.a_ready(cur);
    if constexpr (SP2) {
        PG8_STAGE(PG8_SB(0, 0), cB, voffB); PG8_STAGE(PG8_SB(0, 1), cB + hstep, voffB); PG8_STAGE(PG8_SA(0, 0), cA, voffA); PG8_STAGE(PG8_SA(0, 1), cA + hstep, voffA);
        if (wr == 1) PG8_BAR;
        PG8_WAIT_V(2); PG8_BAR;
        PG8_STAGE(PG8_SB(1, 0), cB + kstep, voffB); PG8_STAGE(PG8_SA(1, 0), cA + kstep, voffA); PG8_STAGE(PG8_SB(1, 1), cB + hstep + kstep, voffB);
        PG8_WAIT_V(6); PG8_BAR;
    } else {
        PG8_STAGE(PG8_SB(0, 0), cB, voffB); PG8_STAGE(PG8_SA(0, 0), cA, voffA); PG8_STAGE(PG8_SB(0, 1), cB + hstep, voffB); PG8_STAGE(PG8_SA(0, 1), cA + hstep, voffA);
        if (wr == 1) PG8_BAR;
        PG8_WAIT_V(4); PG8_BAR;
        PG8_STAGE(PG8_SB(1, 0), cB + kstep, voffB); PG8_STAGE(PG8_SA(1, 0), cA + kstep, voffA); PG8_STAGE(PG8_SB(1, 1), cB + hstep + kstep, voffB);
        PG8_WAIT_V(6); PG8_BAR;
    }
    for (;;) {
        const bool has_next = S.next(ui + 1, nxt);
        const char* nA = has_next ? (const char*)g.A + (size_t)nxt.pm * tstep : cA; const char* nB = has_next ? (const char*)g.Bt + (size_t)nxt.pn * tstep : cB;
        for (int t = 0; t < nt; t += 2) {
            const bool last = (t == nt - 2);
            const char* a1 = cA + (size_t)(t + 1) * kstep;
            const char* a2 = last ? nA : cA + (size_t)(t + 2) * kstep; const char* b2 = last ? nB : cB + (size_t)(t + 2) * kstep;
            const char* a3 = a2 + kstep; const char* b3 = b2 + kstep;
            if (last && has_next) S.a_ready(nxt);
            if constexpr (SP2) {
            PG8_LDB(B0, 0, 0); PG8_LDB(B1, 0, 1); PG8_SCHED; PG8_LDA(At, 0, 0); PG8_STAGE(PG8_SA(1, 1), a1 + hstep, voffA);
            PG8_WAIT_V(8); PG8_WAIT_L(0); PG8_BAR; PG8_MMA(0, 0, At, B0); PG8_MMA(0, 1, At, B1); PG8_BAR; PG8_SCHED;
            PG8_LDA(At, 0, 1); PG8_STAGE(PG8_SB(0, 0), b2, voffB); PG8_STAGE(PG8_SB(0, 1), b2 + hstep, voffB); PG8_STAGE(PG8_SA(0, 0), a2, voffA);
            PG8_WAIT_V(8); PG8_WAIT_L(0); PG8_BAR; PG8_MMA(1, 0, At, B0); PG8_MMA(1, 1, At, B1); PG8_BAR; PG8_SCHED;
            PG8_LDB(B0, 1, 0); PG8_LDB(B1, 1, 1); PG8_SCHED; PG8_LDA(At, 1, 0); PG8_STAGE(PG8_SA(0, 1), a2 + hstep, voffA);
            PG8_WAIT_V(8); PG8_WAIT_L(0); PG8_BAR; PG8_MMA(0, 0, At, B0); PG8_MMA(0, 1, At, B1); PG8_BAR; PG8_SCHED;
            PG8_LDA(At, 1, 1); PG8_STAGE(PG8_SB(1, 0), b3, voffB); PG8_STAGE(PG8_SB(1, 1), b3 + hstep, voffB); PG8_STAGE(PG8_SA(1, 0), a3, voffA);
            PG8_WAIT_V(8); PG8_WAIT_L(0); PG8_BAR; PG8_MMA(1, 0, At, B0); PG8_MMA(1, 1, At, B1); PG8_BAR; PG8_SCHED;
            } else {
            PG8_LDB(B0, 0, 0); PG8_SCHED; PG8_LDA(At, 0, 0); PG8_STAGE(PG8_SA(1, 1), a1 + hstep, voffA);
            PG8_WAIT_L(8); PG8_BAR; PG8_WAIT_L(0); PG8_MMA(0, 0, At, B0); PG8_BAR; PG8_SCHED;
            PG8_LDB(B1, 0, 1); PG8_STAGE(PG8_SB(0, 0), b2, voffB);
            PG8_BAR; PG8_WAIT_L(0); PG8_MMA(0, 1, At, B1); PG8_BAR;
            PG8_LDA(At, 0, 1); PG8_STAGE(PG8_SA(0, 0), a2, voffA);
            PG8_BAR; PG8_WAIT_L(0); PG8_MMA(1, 0, At, B0); PG8_BAR; PG8_SCHED;
            PG8_STAGE(PG8_SB(0, 1), b2 + hstep, voffB);
            PG8_WAIT_V(6); PG8_BAR; PG8_MMA(1, 1, At, B1); PG8_BAR;
            PG8_LDB(B0, 1, 0); PG8_SCHED; PG8_LDA(At, 1, 0); PG8_STAGE(PG8_SA(0, 1), a2 + hstep, voffA);
            PG8_WAIT_L(8); PG8_BAR; PG8_WAIT_L(0); PG8_MMA(0, 0, At, B0); PG8_BAR; PG8_SCHED;
            PG8_LDB(B1, 1, 1); PG8_STAGE(PG8_SB(1, 0), b3, voffB);
            PG8_BAR; PG8_WAIT_L(0); PG8_MMA(0, 1, At, B1); PG8_BAR;
            PG8_LDA(At, 1, 1); PG8_STAGE(PG8_SA(1, 0), a3, voffA);
            PG8_BAR; PG8_WAIT_L(0); PG8_MMA(1, 0, At, B0); PG8_BAR; PG8_SCHED;
            PG8_STAGE(PG8_SB(1, 1), b3 + hstep, voffB);
            PG8_WAIT_V(6); PG8_BAR; PG8_MMA(1, 1, At, B1); PG8_BAR;
            }
        }
        if constexpr (ALIGN_EPI) { if (wr == 0) PG8_BAR; }
        if constexpr (!Epi::AFTER_DRAIN) { E(acc, cur, wr, wc, fr, fq); S.done(cur); }
        if (!has_next) break;
#pragma unroll
        for (int a = 0; a < 2; ++a)
#pragma unroll
            for (int b = 0; b < 2; ++b)
#pragma unroll
                for (int m = 0; m < 4; ++m)
#pragma unroll
                    for (int n = 0; n < 2; ++n) acc[a][b][m][n] = (f32x4){0.f, 0.f, 0.f, 0.f};
        cur = nxt; cA = nA; cB = nB; ++ui;
        if constexpr (ALIGN_EPI) { if (wr == 1) PG8_BAR; }
    }
    PG8_WAIT_V(0);
    if constexpr (!ALIGN_EPI) { if (wr == 0) PG8_BAR; }
    PG8_BAR;
    if constexpr (Epi::AFTER_DRAIN) { E.fused(acc, cur, wr, wc, fr, fq, lds, wid, lane); S.done(cur); }
#undef PG8_SA
#undef PG8_SB
#undef PG8_STAGE
#undef PG8_LDA
#undef PG8_LDB
#undef PG8_MMA
#undef PG8_WAIT_V
#undef PG8_WAIT_L
#undef PG8_BAR
#undef PG8_SCHED
}
}

#define LAS __attribute__((address_space(3)))
typedef unsigned short bf16;
typedef float f32x4 __attribute__((ext_vector_type(4)));
typedef unsigned u32x4 __attribute__((ext_vector_type(4)));
typedef unsigned u32x2 __attribute__((ext_vector_type(2)));
constexpr int DM = 4096, SEQ = 4096, NB = 2, M = NB * SEQ, BW = 2048, NH = 16, HD = 128, INC = 36864, DEPTH = 2;
constexpr int NT18 = 18;
constexpr float RMS_EPS = 1e-6f, ATT_SCALE = 0.08838834764831845f;
constexpr size_t MiB = 1u << 20;
constexpr size_t WS_CTL = 0, WS_ROPE = 1 * MiB, WS_KMEAN = 2 * MiB, WS_WIN = 4 * MiB, WIN_BYTES = 288 * MiB, WS_WBR = WS_WIN + 2 * WIN_BYTES, WBR_BYTES = 48 * MiB,
                 WS_WO = WS_WBR + 2 * WBR_BYTES, WO_BYTES = 32 * MiB, WS_H = WS_WO + 2 * WO_BYTES, WS_T = WS_H + 64 * MiB, T_BYTES = 32 * MiB, WS_OBR = WS_T + NT18 * T_BYTES,
                 WS_TT = WS_OBR + 96 * MiB, WS_Y = WS_TT + 3 * 128 * MiB, WS_OUT = WS_Y + 64 * MiB, WS_END = WS_OUT + 128 * MiB;

__device__ __forceinline__ float bf2f(unsigned short b) { return __uint_as_float(((unsigned)b) << 16); }
__device__ __forceinline__ unsigned f2bf(float f) { unsigned u = __float_as_uint(f); return (u + 0x7fffu + ((u >> 16) & 1u)) >> 16; }
__device__ __forceinline__ unsigned pk2(float lo, float hi) { return f2bf(lo) | (f2bf(hi) << 16); }
__device__ __forceinline__ float wave_sum(float v) {
#pragma unroll
    for (int o = 1; o < 64; o <<= 1) v += __shfl_xor(v, o);
    return v;
}
__device__ __forceinline__ float sigmoidf_(float z) { return 1.0f / (1.0f + __expf(-z)); }
__device__ __forceinline__ float siluf_(float z) { return z / (1.0f + __expf(-z)); }

__device__ __forceinline__ void transpose_item(const float* W, int K, int N, bf16* WT, int row_off, LAS float* scr, int item, int lane) {
    const int nblk = N / 32, kb = item / nblk, nb = item % nblk, k0 = 64 * kb, n0 = 32 * nb;
#pragma unroll 8
    for (int i = 0; i < 32; ++i) { const int kk = 2 * i + (lane >> 5); scr[kk * 33 + (lane & 31)] = W[(size_t)(k0 + kk) * N + n0 + (lane & 31)]; }
    asm volatile("s_waitcnt lgkmcnt(0)" ::: "memory");
    const int c = lane & 7;
#pragma unroll
    for (int j = 0; j < 4; ++j) { const int n = (lane >> 3) + 8 * j; const LAS float* s = scr + (8 * c) * 33 + n;
        u32x4 o; o.x = pk2(s[0 * 33], s[1 * 33]); o.y = pk2(s[2 * 33], s[3 * 33]); o.z = pk2(s[4 * 33], s[5 * 33]); o.w = pk2(s[6 * 33], s[7 * 33]);
        *(u32x4*)(WT + (size_t)(row_off + n0 + n) * K + k0 + 8 * c) = o; }
    asm volatile("s_waitcnt lgkmcnt(0)" ::: "memory");
}
__global__ __launch_bounds__(256) void k_transpose(const float* W, int K, int N, bf16* WT) {
    __shared__ float scr_[4][64 * 33];
    const int wave = threadIdx.x >> 6, lane = threadIdx.x & 63; const int nitems = (K / 64) * (N / 32);
    LAS float* scr = (LAS float*)&scr_[wave][0];
    for (int it = blockIdx.x * 4 + wave; it < nitems; it += gridDim.x * 4) transpose_item(W, K, N, WT, 0, scr, it, lane);
}
__global__ __launch_bounds__(256) void k_rope_table(float2* tab) {
    const int idx = blockIdx.x * 256 + threadIdx.x; if (idx >= SEQ * 16) return;
    const int pos = idx >> 4, i = idx & 15;
    const float inv = exp2f(-(float)i * (18.931568569324174f / 16.0f));
    const float ang = (float)pos * inv;
    const double a = (double)ang; const double kq = __builtin_rint(a * 0.63661977236758134308);
    const double r = (a - kq * 1.5707963267948966192) - kq * 6.123233995736766e-17; const double r2 = r * r;
    const double sr = r * (1.0 + r2 * (-1.0 / 6 + r2 * (1.0 / 120 + r2 * (-1.0 / 5040 + r2 * (1.0 / 362880 + r2 * (-1.0 / 39916800 + r2 * (1.0 / 6227020800.0)))))));
    const double cr = 1.0 + r2 * (-0.5 + r2 * (1.0 / 24 + r2 * (-1.0 / 720 + r2 * (1.0 / 40320 + r2 * (-1.0 / 3628800 + r2 * (1.0 / 479001600.0 + r2 * (-1.0 / 87178291200.0)))))));
    const int q = ((int)kq) & 3; double s, c;
    if (q == 0) { s = sr; c = cr; } else if (q == 1) { s = cr; c = -sr; } else if (q == 2) { s = -sr; c = -cr; } else { s = -cr; c = sr; }
    tab[idx] = make_float2((float)c, (float)s);
}
__global__ __launch_bounds__(256) void k_rmsnorm_bf16(const float* x, const float* g, bf16* out) {
    const int row = blockIdx.x * 4 + (threadIdx.x >> 6), lane = threadIdx.x & 63;
    const f32x4* xr = (const f32x4*)(x + (size_t)row * DM) + lane; f32x4 v[16]; float s = 0.f;
#pragma unroll
    for (int j = 0; j < 16; ++j) { v[j] = xr[64 * j]; s += (v[j].x * v[j].x + v[j].y * v[j].y) + (v[j].z * v[j].z + v[j].w * v[j].w); }
    const float rs = 1.0f / sqrtf(wave_sum(s) * (1.0f / DM) + RMS_EPS);
    u32x2* o = (u32x2*)(out + (size_t)row * DM) + lane;
#pragma unroll
    for (int j = 0; j < 16; ++j) { const f32x4 gv = ((const f32x4*)g)[lane + 64 * j]; u32x2 w; w.x = pk2(v[j].x * rs * gv.x, v[j].y * rs * gv.y); w.y = pk2(v[j].z * rs * gv.z, v[j].w * rs * gv.w); o[64 * j] = w; }
}
__global__ __launch_bounds__(256) void k_rope(bf16* T, const float2* tab) {
    const int idx = blockIdx.x * 256 + threadIdx.x;
    const int i = idx & 15, h = (idx >> 4) & 15, row = idx >> 8; if (row >= M) return;
    bf16* p = T + (size_t)row * BW + h * HD; const float x1 = bf2f(p[i]), x2 = bf2f(p[16 + i]); const float2 cs = tab[(row & (SEQ - 1)) * 16 + i];
    p[i] = (bf16)f2bf(x1 * cs.x - x2 * cs.y); p[16 + i] = (bf16)f2bf(x2 * cs.x + x1 * cs.y);
}
__global__ __launch_bounds__(256) void k_silu(bf16* T) {
    const size_t idx = (size_t)blockIdx.x * 256 + threadIdx.x; if (idx >= (size_t)M * BW) return; T[idx] = (bf16)f2bf(siluf_(bf2f(T[idx])));
}
__global__ __launch_bounds__(256) void k_sigmoid_bias(bf16* T, const float* bias) {
    const size_t idx = (size_t)blockIdx.x * 256 + threadIdx.x; if (idx >= (size_t)6 * M * BW) return;
    const int col = (int)(idx & (BW - 1)); const int t = (int)(idx / ((size_t)M * BW));
    T[idx] = (bf16)f2bf(sigmoidf_(bf2f(T[idx]) + bias[t * BW + col]));
}
__global__ __launch_bounds__(128) void k_kmean(const bf16* Tk, float* kmean) {
    const int j = blockIdx.x, bh = blockIdx.y, b = bh >> 4, h = bh & 15, d = threadIdx.x; float s = 0.f;
    for (int k = 0; k < 256; ++k) s += bf2f(Tk[(size_t)(b * SEQ + j * 256 + k) * BW + h * HD + d]);
    kmean[(bh * 16 + j) * HD + d] = s * (1.0f / 256.0f);
}
__global__ __launch_bounds__(256) void k_conv(const bf16* Tbb, const bf16* Tbc, const bf16* Tbx, const bf16* Tbz, const float* cw, bf16* out) {
    const size_t idx = (size_t)blockIdx.x * 256 + threadIdx.x; if (idx >= (size_t)M * BW) return;
    const int c = (int)(idx & (BW - 1)); const int row = (int)(idx >> 11), t = row & (SEQ - 1);
    const float x0 = bf2f(Tbc[idx]) * bf2f(Tbx[idx]);
    const float x1 = t >= 1 ? bf2f(Tbc[idx - BW]) * bf2f(Tbx[idx - BW]) : 0.f;
    const float x2 = t >= 2 ? bf2f(Tbc[idx - 2 * BW]) * bf2f(Tbx[idx - 2 * BW]) : 0.f;
    const float y = cw[c] * x2 + cw[BW + c] * x1 + cw[2 * BW + c] * x0;
    out[idx] = (bf16)f2bf(bf2f(Tbb[idx]) * y * bf2f(Tbz[idx]));
}
__device__ __forceinline__ float red16(float v) { v += __shfl_xor(v, 1); v += __shfl_xor(v, 2); v += __shfl_xor(v, 4); v += __shfl_xor(v, 8); return v; }
__device__ __forceinline__ void ld8(const bf16* p, float (&f)[8]) { const u32x4 w = *(const u32x4*)p;
    f[0] = __uint_as_float(w.x << 16); f[1] = __uint_as_float(w.x & 0xffff0000u); f[2] = __uint_as_float(w.y << 16); f[3] = __uint_as_float(w.y & 0xffff0000u);
    f[4] = __uint_as_float(w.z << 16); f[5] = __uint_as_float(w.z & 0xffff0000u); f[6] = __uint_as_float(w.w << 16); f[7] = __uint_as_float(w.w & 0xffff0000u); }
__global__ __launch_bounds__(256) void k_moba_naive(const bf16* Tq, const bf16* Tk, const bf16* Tv, const bf16* Tz, const float* kmean, bf16* out) {
    const int item = blockIdx.x * 4 + (threadIdx.x >> 6), lane = threadIdx.x & 63, kg = lane >> 4, dl = lane & 15;
    const int row = item >> 4, h = item & 15, b = row >> 12, t = row & (SEQ - 1), qb = t >> 8, bh = b * 16 + h;
    float q[8]; ld8(Tq + (size_t)row * BW + h * HD + dl * 8, q);
    float g[16];
#pragma unroll
    for (int j = 0; j < 16; ++j) { float s = 0.f; if (j < qb) { const float* km = kmean + (bh * 16 + j) * HD + dl * 8;
#pragma unroll
            for (int i = 0; i < 8; ++i) s += q[i] * km[i];
            s = red16(s); } else s = -INFINITY; g[j] = s; }
    unsigned sel = 0;
#pragma unroll
    for (int j = 0; j < 16; ++j) { int rank = 0;
#pragma unroll
        for (int jj = 0; jj < 16; ++jj) if (jj != j) rank += (jj < qb && (g[jj] > g[j] || (g[jj] == g[j] && jj < j))) ? 1 : 0;
        if (j < qb && rank < 3) sel |= 1u << j; }
    float m = -INFINITY, l = 0.f, o[8];
#pragma unroll
    for (int i = 0; i < 8; ++i) o[i] = 0.f;
    for (int jb = 0; jb <= qb; ++jb) {
        if (jb < qb && !((sel >> jb) & 1u)) continue;
        const int nit = (jb < qb) ? 64 : ((t & 255) / 4 + 1);
        for (int it = 0; it < nit; ++it) { const int key = jb * 256 + 4 * it + kg; const bool valid = key <= t;
            const size_t off = (size_t)(b * SEQ + (valid ? key : t)) * BW + h * HD + dl * 8;
            float kv[8]; ld8(Tk + off, kv); float s = 0.f;
#pragma unroll
            for (int i = 0; i < 8; ++i) s += q[i] * kv[i];
            s = red16(s) * ATT_SCALE;
            float vv[8]; ld8(Tv + off, vv);
            if (valid) { const float mn = fmaxf(m, s), al = __expf(m - mn), p = __expf(s - mn); l = l * al + p;
#pragma unroll
                for (int i = 0; i < 8; ++i) o[i] = o[i] * al + p * vv[i];
                m = mn; } } }
#pragma unroll
    for (int off = 16; off <= 32; off <<= 1) { const float m2 = __shfl_xor(m, off), l2 = __shfl_xor(l, off); const float Mx = fmaxf(m, m2);
        const float a1 = (m == -INFINITY) ? 0.f : __expf(m - Mx), a2 = (m2 == -INFINITY) ? 0.f : __expf(m2 - Mx); l = l * a1 + l2 * a2;
#pragma unroll
        for (int i = 0; i < 8; ++i) { const float o2 = __shfl_xor(o[i], off); o[i] = o[i] * a1 + o2 * a2; }
        m = Mx; }
    if (kg == 0) { float z[8]; const size_t off = (size_t)row * BW + h * HD + dl * 8; ld8(Tz + off, z); const float il = 1.0f / l; u32x4 w;
        w.x = pk2(o[0] * il * z[0], o[1] * il * z[1]); w.y = pk2(o[2] * il * z[2], o[3] * il * z[3]); w.z = pk2(o[4] * il * z[4], o[5] * il * z[5]); w.w = pk2(o[6] * il * z[6], o[7] * il * z[7]);
        *(u32x4*)(out + off) = w; }
}
__global__ __launch_bounds__(256) void k_sb_naive(const bf16* Tq, const bf16* Tk, const bf16* Tv, const bf16* Tz, bf16* out) {
    const int item = blockIdx.x * 4 + (threadIdx.x >> 6), lane = threadIdx.x & 63, kg = lane >> 4, dl = lane & 15;
    const int row = item >> 4, h = item & 15, b = row >> 12, t = row & (SEQ - 1);
    float q[8]; ld8(Tq + (size_t)row * BW + h * HD + dl * 8, q);
    float carry = 0.f, o[8];
#pragma unroll
    for (int i = 0; i < 8; ++i) o[i] = 0.f;
    const int nit = (t + 3) / 4;
    for (int it = 0; it < nit; ++it) { const int key = t - 1 - 4 * it - kg; const bool valid = key >= 0;
        const size_t off = (size_t)(b * SEQ + (valid ? key : 0)) * BW + h * HD + dl * 8;
        float kv[8]; ld8(Tk + off, kv); float s = 0.f;
#pragma unroll
        for (int i = 0; i < 8; ++i) s += q[i] * kv[i];
        const float z = red16(s) * ATT_SCALE;
        const float tt = log1pf(__expf(-fabsf(z))); const float ls = fminf(z, 0.f) - tt; float lk = fminf(-z, 0.f) - tt; if (!valid) lk = 0.f;
        const float lk0 = __shfl(lk, dl), lk1 = __shfl(lk, 16 + dl), lk2 = __shfl(lk, 32 + dl), lk3 = __shfl(lk, 48 + dl);
        const float pre = (kg > 0 ? lk0 : 0.f) + (kg > 1 ? lk1 : 0.f) + (kg > 2 ? lk2 : 0.f);
        const float a = valid ? __expf(ls + carry + pre) : 0.f;
        float vv[8]; ld8(Tv + off, vv);
#pragma unroll
        for (int i = 0; i < 8; ++i) o[i] += a * vv[i];
        carry += (lk0 + lk1) + (lk2 + lk3); }
#pragma unroll
    for (int i = 0; i < 8; ++i) { o[i] += __shfl_xor(o[i], 16); o[i] += __shfl_xor(o[i], 32); }
    if (kg == 0) { float z[8]; const size_t off = (size_t)row * BW + h * HD + dl * 8; ld8(Tz + off, z); u32x4 w;
        w.x = pk2(o[0] * z[0], o[1] * z[1]); w.y = pk2(o[2] * z[2], o[3] * z[3]); w.z = pk2(o[4] * z[4], o[5] * z[5]); w.w = pk2(o[6] * z[6], o[7] * z[7]);
        *(u32x4*)(out + off) = w; }
}
__global__ __launch_bounds__(256) void k_combine(const float* TT, const bf16* G6, bf16* Y) {
    const size_t idx = (size_t)blockIdx.x * 256 + threadIdx.x; if (idx >= (size_t)M * DM) return;
    const int c = (int)(idx & (DM - 1)); const size_t row = idx >> 12; float y = 0.f;
#pragma unroll
    for (int i = 0; i < 3; ++i) y += bf2f(G6[((size_t)(2 * i + (c >> 11)) * M + row) * BW + (c & (BW - 1))]) * TT[(size_t)i * M * DM + idx];
    Y[idx] = (bf16)f2bf(y);
}
__global__ __launch_bounds__(256) void k_final(const float* x, const float* outp, const float* g, float* xn) {
    const int row = blockIdx.x * 4 + (threadIdx.x >> 6), lane = threadIdx.x & 63;
    const f32x4* orow = (const f32x4*)(outp + (size_t)row * DM) + lane; f32x4 v[16]; float s = 0.f;
#pragma unroll
    for (int j = 0; j < 16; ++j) { v[j] = orow[64 * j]; s += (v[j].x * v[j].x + v[j].y * v[j].y) + (v[j].z * v[j].z + v[j].w * v[j].w); }
    const float rs = 1.0f / sqrtf(wave_sum(s) * (1.0f / DM) + RMS_EPS);
    const f32x4* xr = (const f32x4*)(x + (size_t)row * DM) + lane; f32x4* xo = (f32x4*)(xn + (size_t)row * DM) + lane;
#pragma unroll
    for (int j = 0; j < 16; ++j) { const f32x4 gv = ((const f32x4*)g)[lane + 64 * j]; const f32x4 xv = xr[64 * j]; xo[64 * j] = xv + v[j] * rs * gv; }
}
__global__ __launch_bounds__(512, 2) void k_gemm_bf16(pg8::Gemm g, pg8::EpiBf16 E) {
    extern __shared__ __attribute__((aligned(16))) unsigned char shm[];
    pg8::StaticOrder S; S.init(g.M, g.N, (int)gridDim.x, (int)blockIdx.x);
    pg8::gemm_phase<pg8::EpiBf16, pg8::StaticOrder, true, true>((PG8_LAS unsigned char*)shm, g, S, E);
}
__global__ __launch_bounds__(512, 2) void k_gemm_f32(pg8::Gemm g, pg8::EpiF32 E) {
    extern __shared__ __attribute__((aligned(16))) unsigned char shm[];
    pg8::StaticOrder S; S.init(g.M, g.N, (int)gridDim.x, (int)blockIdx.x);
    pg8::gemm_phase<pg8::EpiF32, pg8::StaticOrder, true, true>((PG8_LAS unsigned char*)shm, g, S, E);
}

extern "C" void kernel_launch(void* const* d_in, const int* in_sizes, int n_in, void* d_out, int out_size, void* d_ws, size_t ws_size, hipStream_t stream) {
    static int ok = 0;
    if (ok == 0) {
        if (n_in != 10 || in_sizes[0] != M * DM || out_size != M * DM || ws_size < WS_END) { fprintf(stderr, "kernel_launch: shape mismatch (n_in %d, in0 %d, out %d, ws %zu, need %zu)\n", n_in, n_in > 0 ? in_sizes[0] : -1, out_size, ws_size, (size_t)WS_END); ok = -1; return; }
        if (hipFuncSetAttribute((const void*)k_gemm_bf16, hipFuncAttributeMaxDynamicSharedMemorySize, pg8::STAGE_BYTES) != hipSuccess ||
            hipFuncSetAttribute((const void*)k_gemm_f32, hipFuncAttributeMaxDynamicSharedMemorySize, pg8::STAGE_BYTES) != hipSuccess) { fprintf(stderr, "kernel_launch: hipFuncSetAttribute failed\n"); ok = -1; return; }
        ok = 1;
    }
    if (ok < 0) return;
    const float* x = (const float*)d_in[0]; const float* pre_g = (const float*)d_in[1]; const float* post_g = (const float*)d_in[2]; const float* w_in = (const float*)d_in[3];
    const float* b_merge = (const float*)d_in[4]; const float* conv_w = (const float*)d_in[5]; const float* w_br[3] = {(const float*)d_in[6], (const float*)d_in[7], (const float*)d_in[8]};
    const float* w_out = (const float*)d_in[9];
    unsigned char* ws = (unsigned char*)d_ws; float* out = (float*)d_out;
    float2* rope = (float2*)(ws + WS_ROPE); float* kmean = (float*)(ws + WS_KMEAN); bf16* H = (bf16*)(ws + WS_H); bf16* T = (bf16*)(ws + WS_T); bf16* OBR = (bf16*)(ws + WS_OBR);
    float* TT = (float*)(ws + WS_TT); bf16* Y = (bf16*)(ws + WS_Y); float* OUT = (float*)(ws + WS_OUT);
    const size_t TE = (size_t)M * BW;
    for (int L = 0; L < DEPTH; ++L) {
        k_transpose<<<2048, 256, 0, stream>>>(w_in + (size_t)L * DM * INC, DM, INC, (bf16*)(ws + WS_WIN + L * WIN_BYTES));
        for (int i = 0; i < 3; ++i) k_transpose<<<2048, 256, 0, stream>>>(w_br[i] + (size_t)L * BW * DM, BW, DM, (bf16*)(ws + WS_WBR + L * WBR_BYTES) + (size_t)i * DM * BW);
        k_transpose<<<2048, 256, 0, stream>>>(w_out + (size_t)L * DM * DM, DM, DM, (bf16*)(ws + WS_WO + L * WO_BYTES));
    }
    k_rope_table<<<SEQ * 16 / 256, 256, 0, stream>>>(rope);
    for (int L = 0; L < DEPTH; ++L) {
        const float* xc = L == 0 ? x : out;
        k_rmsnorm_bf16<<<M / 4, 256, 0, stream>>>(xc, pre_g + L * DM, H);
        { pg8::Gemm g{H, (const bf16*)(ws + WS_WIN + L * WIN_BYTES), M, INC, DM, 0}; pg8::EpiBf16 E{T, BW, BW, TE};
          k_gemm_bf16<<<256, 512, pg8::STAGE_BYTES, stream>>>(g, E); }
        k_rope<<<M * 256 / 256, 256, 0, stream>>>(T + 0 * TE, rope); k_rope<<<M * 256 / 256, 256, 0, stream>>>(T + 1 * TE, rope);
        k_silu<<<(unsigned)(TE / 256), 256, 0, stream>>>(T + 3 * TE); k_silu<<<(unsigned)(TE / 256), 256, 0, stream>>>(T + 7 * TE); k_silu<<<(unsigned)(TE / 256), 256, 0, stream>>>(T + 11 * TE);
        k_sigmoid_bias<<<(unsigned)(6 * TE / 256), 256, 0, stream>>>(T + 12 * TE, b_merge + L * 3 * DM);
        k_kmean<<<dim3(16, 32), 128, 0, stream>>>(T + 1 * TE, kmean);
        k_conv<<<(unsigned)(TE / 256), 256, 0, stream>>>(T + 4 * TE, T + 5 * TE, T + 6 * TE, T + 7 * TE, conv_w + L * 3 * BW, OBR + 1 * TE);
        k_moba_naive<<<M * NH / 4, 256, 0, stream>>>(T + 0 * TE, T + 1 * TE, T + 2 * TE, T + 3 * TE, kmean, OBR + 0 * TE);
        k_sb_naive<<<M * NH / 4, 256, 0, stream>>>(T + 8 * TE, T + 9 * TE, T + 10 * TE, T + 11 * TE, OBR + 2 * TE);
        for (int i = 0; i < 3; ++i) { pg8::Gemm g{OBR + i * TE, (const bf16*)(ws + WS_WBR + L * WBR_BYTES) + (size_t)i * DM * BW, M, DM, BW, 0}; pg8::EpiF32 E{TT + (size_t)i * M * DM, nullptr, DM, 0};
          k_gemm_f32<<<256, 512, pg8::STAGE_BYTES, stream>>>(g, E); }
        k_combine<<<(unsigned)((size_t)M * DM / 256), 256, 0, stream>>>(TT, T + 12 * TE, Y);
        { pg8::Gemm g{Y, (const bf16*)(ws + WS_WO + L * WO_BYTES), M, DM, DM, 0}; pg8::EpiF32 E{OUT, nullptr, DM, 0};
          k_gemm_f32<<<256, 512, pg8::STAGE_BYTES, stream>>>(g, E); }
        k_final<<<M / 4, 256, 0, stream>>>(xc, OUT, post_g + L * DM, out);
    }
}
```

```cpp
#include <hip/hip_runtime.h>
#include <cstdio>
#include <cstdint>
#define LAS __attribute__((address_space(3)))
#define GAS __attribute__((address_space(1)))
__device__ __forceinline__ int mk_lane() { int l; asm volatile("v_mbcnt_lo_u32_b32 %0, -1, 0\n\tv_mbcnt_hi_u32_b32 %0, -1, %0" : "=v"(l)); return l; }
namespace pg8 {
#define PG8_LAS __attribute__((address_space(3)))
typedef unsigned short bf16_t;
typedef short bf16x8 __attribute__((ext_vector_type(8)));
typedef float f32x4 __attribute__((ext_vector_type(4)));
typedef unsigned u32x4 __attribute__((ext_vector_type(4)));
typedef int i32x4 __attribute__((ext_vector_type(4)));
constexpr int BM = 256, BK = 64, HALF = 128, HTB = HALF * BK * 2  , STAGE_BYTES = 8 * HTB, NXCD = 8, WGM = 4;

__host__ __device__ __forceinline__ int lds_byte(int r, int c) { const int st = (r >> 4) * 2 + (c >> 5), rr = r & 15, cc = c & 31, ob = rr * 64 + cc * 2; return st * 1024 + (ob ^ (((ob >> 9) & 1) << 5)); }
__host__ __device__ __forceinline__ void stage_rc(int b, int& R, int& C) { const int st = b / 1024, sb = b % 1024, swz = sb ^ (((sb >> 9) & 1) << 5); R = (st >> 1) * 16 + swz / 64; C = (st & 1) * 32 + (swz % 64) / 2; }
__host__ __device__ __forceinline__ int perm32(int rho) { const int n = rho >> 4, i = rho & 15; return 8 * (i >> 2) + 4 * n + (i & 3); }

struct Unit { int pm, pn; };
struct Gemm { const bf16_t* A; const bf16_t* Bt; int M, N, K, pad; };

struct StaticOrder {
    int nM, nN, nwg, G, c;
    __host__ __device__ void init(int M, int N, int G_, int c_) { nM = M / BM; nN = N / BM; nwg = nM * nN; G = G_; c = c_; }
    __host__ __device__ bool next(int i, Unit& u) const {
        const long L = (long)i * G + c; if (L >= nwg) return false;
        int wgid = (int)L; { const int q = nwg / NXCD, r = nwg % NXCD, xcd = wgid % NXCD, off = wgid / NXCD; wgid = (xcd < r ? xcd * (q + 1) : r * (q + 1) + (xcd - r) * q) + off; }
        const int nig = WGM * nN, gid = wgid / nig, fm = gid * WGM, gsz = (nM - fm) < WGM ? (nM - fm) : WGM;
        u.pm = fm + ((wgid % nig) % gsz); u.pn = (wgid % nig) / gsz; return true;
    }
    __device__ __forceinline__ void a_ready(const Unit&) const {}
    __device__ __forceinline__ void done(const Unit&) const {}
};

typedef float f32x2_t __attribute__((ext_vector_type(2))); typedef __bf16 bf16x2_t __attribute__((ext_vector_type(2)));
__device__ __forceinline__ unsigned cvt_pk_bf16(float lo, float hi) { const f32x2_t v = {lo, hi}; const bf16x2_t b = __builtin_convertvector(v, bf16x2_t); return __builtin_bit_cast(unsigned, b); }
typedef float f32x2 __attribute__((ext_vector_type(2)));
#ifndef PG8_SPLIT
#define PG8_SPLIT 0
#endif
template <class Epi, class Sched, bool ALIGN_EPI = false, bool SP2 = false, bool I8 = false>
__device__ __forceinline__ void gemm_phase(PG8_LAS unsigned char* lds, const Gemm g, const Sched& S, const Epi& E, const int wave_s) {
    const int tid = wave_s * 64 + mk_lane(),
              wid = __builtin_amdgcn_readfirstlane(tid >> 6), lane = tid & 63, wr = wid >> 2, wc = wid & 3, fr = lane & 15, fq = lane >> 4;
    const int K = g.K, nt = K / BK;
    unsigned voffA[2], voffB[2];
#pragma unroll
    for (int i = 0; i < 2; ++i) { int R, C; stage_rc(tid * 16 + i * 8192, R, C); const int Rb = Epi::PERM ? ((R & ~31) + perm32(R & 31)) : R;
        voffA[i] = (unsigned)(R * K + C) * 2u; voffB[i] = (unsigned)(Rb * K + C) * 2u; }
    const size_t kstep = (size_t)(BK * 2);
    const size_t hstep = (size_t)HALF * K * 2;
    const size_t tstep = 2 * hstep;
    const unsigned ldsw = (unsigned)wid * 1024u;
    const int aoff = lds_byte(wr * 64 + fr, fq * 8), boff = lds_byte(wc * 32 + fr, fq * 8);
#define PG8_SA(b, h) (((b) * 2 + (h)) * HTB)
#define PG8_SB(b, h) ((4 + (b) * 2 + (h)) * HTB)
#define PG8_STAGE(bufoff, gbase, voff) do { _Pragma("unroll") for (int _i = 0; _i < 2; ++_i) \
        __builtin_amdgcn_global_load_lds((const unsigned*)((const char*)(gbase) + (voff)[_i]), (PG8_LAS unsigned*)(lds + (bufoff) + ldsw + _i * 8192), 16, 0, 0); } while (0)
#define PG8_LDA(dst, b, h) do { _Pragma("unroll") for (int m = 0; m < 4; ++m) _Pragma("unroll") for (int k = 0; k < 2; ++k) dst[m][k] = *(const PG8_LAS bf16x8*)(lds + PG8_SA(b, h) + aoff + m * 2048 + k * 1024); } while (0)
#define PG8_LDB(dst, b, h) do { _Pragma("unroll") for (int n = 0; n < 2; ++n) _Pragma("unroll") for (int k = 0; k < 2; ++k) dst[n][k] = *(const PG8_LAS bf16x8*)(lds + PG8_SB(b, h) + boff + n * 2048 + k * 1024); } while (0)
#define PG8_MMA(ai, bj, At, Bt) do { __builtin_amdgcn_s_setprio(1); _Pragma("unroll") for (int m = 0; m < 4; ++m) _Pragma("unroll") for (int n = 0; n < 2; ++n) _Pragma("unroll") for (int k = 0; k < 2; ++k) \
        { if constexpr (I8) acc[ai][bj][m][n] = __builtin_bit_cast(f32x4, __builtin_amdgcn_mfma_i32_16x16x64_i8(__builtin_bit_cast(i32x4, Bt[n][k]), __builtin_bit_cast(i32x4, At[m][k]), __builtin_bit_cast(i32x4, acc[ai][bj][m][n]), 0, 0, 0)); \
          else acc[ai][bj][m][n] = __builtin_amdgcn_mfma_f32_16x16x32_bf16(Bt[n][k], At[m][k], acc[ai][bj][m][n], 0, 0, 0); } __builtin_amdgcn_s_setprio(0); } while (0)
#define PG8_WAIT_V(n) asm volatile("s_waitcnt vmcnt(" #n ")" ::: "memory")
#define PG8_WAIT_L(n) asm volatile("s_waitcnt lgkmcnt(" #n ")" ::: "memory")
#define PG8_BAR __builtin_amdgcn_s_barrier()
#define PG8_SCHED __builtin_amdgcn_sched_barrier(0)
    Unit cur, nxt; int ui = 0;
    if (!S.next(0, cur)) return;
    f32x4 acc[2][2][4][2];
#pragma unroll
    for (int a = 0; a < 2; ++a)
#pragma unroll
        for (int b = 0; b < 2; ++b)
#pragma unroll
            for (int m = 0; m < 4; ++m)
#pragma unroll
                for (int n = 0; n < 2; ++n) acc[a][b][m][n] = (f32x4){0.f, 0.f, 0.f, 0.f};
    bf16x8 At[4][2], B0[2][2], B1[2][2];
    const char* cA = (const char*)g.A + (size_t)cur.pm * tstep; const char* cB = (const char*)g.Bt + (size_t)cur.pn * tstep;
    S.a_ready(cur);
    if constexpr (SP2) {
        PG8_STAGE(PG8_SB(0, 0), cB, voffB); PG8_STAGE(PG8_SB(0, 1), cB + hstep, voffB); PG8_STAGE(PG8_SA(0, 0), cA, voffA); PG8_STAGE(PG8_SA(0, 1), cA + hstep, voffA);
        if (wr == 1) PG8_BAR;
        PG8_WAIT_V(2); PG8_BAR;
        PG8_STAGE(PG8_SB(1, 0), cB + kstep, voffB); PG8_STAGE(PG8_SA(1, 0), cA + kstep, voffA); PG8_STAGE(PG8_SB(1, 1), cB + hstep + kstep, voffB);
        PG8_WAIT_V(6); PG8_BAR;
    } else {
        PG8_STAGE(PG8_SB(0, 0), cB, voffB); PG8_STAGE(PG8_SA(0, 0), cA, voffA); PG8_STAGE(PG8_SB(0, 1), cB + hstep, voffB); PG8_STAGE(PG8_SA(0, 1), cA + hstep, voffA);
        if (wr == 1) PG8_BAR;
        PG8_WAIT_V(4); PG8_BAR;
        PG8_STAGE(PG8_SB(1, 0), cB + kstep, voffB); PG8_STAGE(PG8_SA(1, 0), cA + kstep, voffA); PG8_STAGE(PG8_SB(1, 1), cB + hstep + kstep, voffB);
        PG8_WAIT_V(6); PG8_BAR;
    }
    for (;;) {
        const bool has_next = S.next(ui + 1, nxt);
        const char* nA = has_next ? (const char*)g.A + (size_t)nxt.pm * tstep : cA; const char* nB = has_next ? (const char*)g.Bt + (size_t)nxt.pn * tstep : cB;
        for (int t = 0; t < nt; t += 2) {
            const bool last = (t == nt - 2);
            const char* a1 = cA + (size_t)(t + 1) * kstep;
            const char* a2 = last ? nA : cA + (size_t)(t + 2) * kstep; const char* b2 = last ? nB : cB + (size_t)(t + 2) * kstep;
            const char* a3 = a2 + kstep; const char* b3 = b2 + kstep;
            if (last && has_next) S.a_ready(nxt);
            if constexpr (SP2) {
            PG8_LDB(B0, 0, 0); PG8_LDB(B1, 0, 1); PG8_SCHED; PG8_LDA(At, 0, 0); PG8_STAGE(PG8_SA(1, 1), a1 + hstep, voffA);
            PG8_WAIT_V(8); PG8_WAIT_L(0); PG8_BAR; PG8_MMA(0, 0, At, B0); PG8_MMA(0, 1, At, B1); PG8_BAR; PG8_SCHED;
#if PG8_SPLIT
            PG8_LDA(At, 0, 1); PG8_STAGE(PG8_SB(0, 0), b2, voffB); PG8_STAGE(PG8_SB(0, 1), b2 + hstep, voffB);
            PG8_WAIT_V(6); PG8_WAIT_L(0); PG8_BAR; PG8_MMA(1, 0, At, B0); PG8_SCHED; PG8_STAGE(PG8_SA(0, 0), a2, voffA); PG8_SCHED; PG8_MMA(1, 1, At, B1); PG8_BAR; PG8_SCHED;
#else
            PG8_LDA(At, 0, 1); PG8_STAGE(PG8_SB(0, 0), b2, voffB); PG8_STAGE(PG8_SB(0, 1), b2 + hstep, voffB); PG8_STAGE(PG8_SA(0, 0), a2, voffA);
            PG8_WAIT_V(8); PG8_WAIT_L(0); PG8_BAR; PG8_MMA(1, 0, At, B0); PG8_MMA(1, 1, At, B1); PG8_BAR; PG8_SCHED;
#endif
            PG8_LDB(B0, 1, 0); PG8_LDB(B1, 1, 1); PG8_SCHED; PG8_LDA(At, 1, 0); PG8_STAGE(PG8_SA(0, 1), a2 + hstep, voffA);
            PG8_WAIT_V(8); PG8_WAIT_L(0); PG8_BAR; PG8_MMA(0, 0, At, B0); PG8_MMA(0, 1, At, B1); PG8_BAR; PG8_SCHED;
#if PG8_SPLIT
            PG8_LDA(At, 1, 1); PG8_STAGE(PG8_SB(1, 0), b3, voffB); PG8_STAGE(PG8_SB(1, 1), b3 + hstep, voffB);
            PG8_WAIT_V(6); PG8_WAIT_L(0); PG8_BAR; PG8_MMA(1, 0, At, B0); PG8_SCHED; PG8_STAGE(PG8_SA(1, 0), a3, voffA); PG8_SCHED; PG8_MMA(1, 1, At, B1); PG8_BAR; PG8_SCHED;
#else
            PG8_LDA(At, 1, 1); PG8_STAGE(PG8_SB(1, 0), b3, voffB); PG8_STAGE(PG8_SB(1, 1), b3 + hstep, voffB); PG8_STAGE(PG8_SA(1, 0), a3, voffA);
            PG8_WAIT_V(8); PG8_WAIT_L(0); PG8_BAR; PG8_MMA(1, 0, At, B0); PG8_MMA(1, 1, At, B1); PG8_BAR; PG8_SCHED;
#endif
            } else {
            PG8_LDB(B0, 0, 0); PG8_SCHED; PG8_LDA(At, 0, 0); PG8_STAGE(PG8_SA(1, 1), a1 + hstep, voffA);
            PG8_WAIT_L(8); PG8_BAR; PG8_WAIT_L(0); PG8_MMA(0, 0, At, B0); PG8_BAR; PG8_SCHED;
            PG8_LDB(B1, 0, 1); PG8_STAGE(PG8_SB(0, 0), b2, voffB);
            PG8_BAR; PG8_WAIT_L(0); PG8_MMA(0, 1, At, B1); PG8_BAR;
            PG8_LDA(At, 0, 1); PG8_STAGE(PG8_SA(0, 0), a2, voffA);
            PG8_BAR; PG8_WAIT_L(0); PG8_MMA(1, 0, At, B0); PG8_BAR; PG8_SCHED;
            PG8_STAGE(PG8_SB(0, 1), b2 + hstep, voffB);
            PG8_WAIT_V(6); PG8_BAR; PG8_MMA(1, 1, At, B1); PG8_BAR;
            PG8_LDB(B0, 1, 0); PG8_SCHED; PG8_LDA(At, 1, 0); PG8_STAGE(PG8_SA(0, 1), a2 + hstep, voffA);
            PG8_WAIT_L(8); PG8_BAR; PG8_WAIT_L(0); PG8_MMA(0, 0, At, B0); PG8_BAR; PG8_SCHED;
            PG8_LDB(B1, 1, 1); PG8_STAGE(PG8_SB(1, 0), b3, voffB);
            PG8_BAR; PG8_WAIT_L(0); PG8_MMA(0, 1, At, B1); PG8_BAR;
            PG8_LDA(At, 1, 1); PG8_STAGE(PG8_SA(1, 0), a3, voffA);
            PG8_BAR; PG8_WAIT_L(0); PG8_MMA(1, 0, At, B0); PG8_BAR; PG8_SCHED;
            PG8_STAGE(PG8_SB(1, 1), b3 + hstep, voffB);
            PG8_WAIT_V(6); PG8_BAR; PG8_MMA(1, 1, At, B1); PG8_BAR;
            }
        }
        if constexpr (ALIGN_EPI) { if (wr == 0) PG8_BAR; }
        if constexpr (!Epi::AFTER_DRAIN) { E(acc, cur, wr, wc, fr, fq); S.done(cur); }
        if (!has_next) break;
        if (!Epi::keep(cur)) {
#pragma unroll
        for (int a = 0; a < 2; ++a)
#pragma unroll
            for (int b = 0; b < 2; ++b)
#pragma unroll
                for (int m = 0; m < 4; ++m)
#pragma unroll
                    for (int n = 0; n < 2; ++n) acc[a][b][m][n] = (f32x4){0.f, 0.f, 0.f, 0.f};
        }
        cur = nxt; cA = nA; cB = nB; ++ui;
        if constexpr (ALIGN_EPI) { if (wr == 1) PG8_BAR; }
    }
    PG8_WAIT_V(0);
    if constexpr (!ALIGN_EPI) { if (wr == 0) PG8_BAR; }
    PG8_BAR;
    if constexpr (Epi::AFTER_DRAIN) { E.fused(acc, cur, wr, wc, fr, fq, lds, wid, lane); S.done(cur); }
#undef PG8_SA
#undef PG8_SB
#undef PG8_STAGE
#undef PG8_LDA
#undef PG8_LDB
#undef PG8_MMA
#undef PG8_WAIT_V
#undef PG8_WAIT_L
#undef PG8_BAR
#undef PG8_SCHED
}
}
#define XB_TMO      128
#define XB_XCNT(j)  (256  + 64 * (j))
#define XB_XSUB(j)  (1280 + 64 * (j))
#define XB_XGEN(j)  (2304 + 64 * (j))
#define XB_TOP      3328
#define XB_TOPGEN   3392
#define XCD_BAR_WORDS 3456
#define XB_SPIN_CAP (1u << 18)

__device__ __forceinline__ unsigned xb_ld(unsigned* p)              { return __hip_atomic_load(p, __ATOMIC_RELAXED, __HIP_MEMORY_SCOPE_AGENT); }
__device__ __forceinline__ unsigned xb_add(unsigned* p, unsigned v) { return __hip_atomic_fetch_add(p, v, __ATOMIC_RELAXED, __HIP_MEMORY_SCOPE_AGENT); }
__device__ __forceinline__ unsigned xb_xcc_id() { return (unsigned)__builtin_amdgcn_s_getreg((3 << 11) | 20) & 0xFu; }
#define XB_SPIN(cond, bar) do { unsigned _sp = 0; while (cond) { __builtin_amdgcn_s_sleep(1); \
    if ((++_sp & 255u) == 0u) { if (xb_ld(&(bar)[XB_TMO])) break; if (_sp > XB_SPIN_CAP) { atomicAdd(&(bar)[XB_TMO], 1u); break; } } } } while (0)

struct XcdBarrier {
    unsigned* bar; unsigned x;
    volatile LAS unsigned* st;
};

__device__ __forceinline__ XcdBarrier xcd_barrier_post(unsigned* bar, volatile LAS unsigned* st) {
    XcdBarrier b; b.bar = bar; b.x = xb_xcc_id(); b.st = st;
    if (threadIdx.x == 0) (void)xb_add(&bar[XB_XCNT(b.x)], 1u);
    return b;
}
__device__ __forceinline__ void xcd_barrier_complete(unsigned* bar, unsigned x, unsigned& nloc, unsigned& nx) {
    const unsigned G = gridDim.x * gridDim.y * gridDim.z;
    unsigned sum, cnt, mine, sp = 0u;
    for (;;) {
        sum = 0u; cnt = 0u; mine = 0u;
#pragma unroll
        for (unsigned j = 0; j < 16; ++j) { const unsigned c = xb_ld(&bar[XB_XCNT(j)]); sum += c; cnt += (c > 0u) ? 1u : 0u; mine = (j == x) ? c : mine; }
        if (sum == G) break;
        __builtin_amdgcn_s_sleep(1);
        if ((++sp & 255u) == 0u) { if (xb_ld(&bar[XB_TMO])) break; if (sp > XB_SPIN_CAP) { atomicAdd(&bar[XB_TMO], 1u); break; } }
    }
    nloc = mine > 0u ? mine : 1u; nx = cnt > 0u ? cnt : 1u;
}

__device__ __forceinline__ void xcd_barrier(const XcdBarrier& b) {
    asm volatile("s_waitcnt vmcnt(0)" ::: "memory");
    __syncthreads();
    if (threadIdx.x == 0) {
        unsigned* bar = b.bar;
        __builtin_amdgcn_s_waitcnt(0);
        unsigned nloc = b.st[0], nx = b.st[1];
        if (nloc == 0u) { xcd_barrier_complete(bar, b.x, nloc, nx); b.st[0] = nloc; b.st[1] = nx; }
        const unsigned old = xb_add(&bar[XB_XSUB(b.x)], 1u);
        const unsigned gen = old / nloc;
        if (old + 1u == (gen + 1u) * nloc) {
            __builtin_amdgcn_fence(__ATOMIC_RELEASE, "agent");
            asm volatile("s_waitcnt vmcnt(0)" ::: "memory");
            const unsigned og = xb_add(&bar[XB_TOP], 1u);
            const unsigned tg = og / nx;
            if (og + 1u == (tg + 1u) * nx) xb_add(&bar[XB_TOPGEN], 1u);
            else XB_SPIN(xb_ld(&bar[XB_TOPGEN]) == tg, bar);
            __builtin_amdgcn_fence(__ATOMIC_ACQUIRE, "agent");
            xb_add(&bar[XB_XGEN(b.x)], 1u);
            asm volatile("s_waitcnt vmcnt(0)" ::: "memory");
        } else {
            XB_SPIN(xb_ld(&bar[XB_XGEN(b.x)]) == gen, bar);
            __builtin_amdgcn_fence(__ATOMIC_ACQUIRE, "agent");
            asm volatile("s_waitcnt vmcnt(0)" ::: "memory");
        }
    }
    __syncthreads();
}

typedef unsigned short bf16;
typedef float f32x4 __attribute__((ext_vector_type(4)));
typedef unsigned u32x4 __attribute__((ext_vector_type(4)));
typedef unsigned u32x2 __attribute__((ext_vector_type(2)));
typedef GAS unsigned gu32;
#define RLX_AGENT __ATOMIC_RELAXED, __HIP_MEMORY_SCOPE_AGENT
constexpr int DM = 4096, SEQ = 4096, NB = 2, M = NB * SEQ, BW = 2048, NH = 16, HD = 128, INC = 36864, DEPTH = 2;
constexpr int NT18 = 18;
constexpr float RMS_EPS = 1e-6f, ATT_SCALE = 0.08838834764831845f;
constexpr size_t MiB = 1u << 20;
constexpr size_t WS_CTL = 0, CTL_ZERO_BYTES = 32768, WS_ROPE = 1 * MiB, WS_KMEAN = 2 * MiB, WS_KM = 3 * MiB, WS_WIN = 4 * MiB, WIN_BYTES = 288 * MiB, WS_WBR = WS_WIN + 2 * WIN_BYTES, WBR_BYTES = 48 * MiB,
                 WS_WO = WS_WBR + 2 * WBR_BYTES, WO_BYTES = 32 * MiB, WS_H = WS_WO + 2 * WO_BYTES, WS_T = WS_H + 64 * MiB, T_BYTES = 32 * MiB, WS_OBR = WS_T + NT18 * T_BYTES,
                 WS_X1 = WS_OBR + 96 * MiB, WS_Y = WS_X1 + 64 * MiB, WS_OUT = WS_Y + 64 * MiB, WS_H8 = WS_OUT + 64 * MiB, WS_Y8 = WS_H8 + 32 * MiB, WS_END = WS_Y8 + 32 * MiB;
constexpr int NGATE = INC - 4 * BW, NPROJ = 4 * BW;
constexpr size_t W8_OFF = 128 * MiB;
constexpr size_t TE = (size_t)M * BW;
constexpr int CW_TMO = 0, CW_QCLAIM = 64, CW_XID = 1024, CW_GRP = 1536, CW_BAR = 4096;
constexpr int NWAVES = 8;
constexpr int RING_BYTES = 131072, LDS_BYTES = 147456, MISC_OFF = LDS_BYTES - 256;
constexpr int PH_PER_LAYER = 7, N_PHASES = 1 + DEPTH * PH_PER_LAYER;
#ifndef MK_PER_PHASE
#define MK_PER_PHASE 0
#endif

__device__ __forceinline__ float bf2f(unsigned short b) { return __uint_as_float(((unsigned)b) << 16); }
__device__ __forceinline__ unsigned f2bf(float f) { unsigned u = __float_as_uint(f); return (u + 0x7fffu + ((u >> 16) & 1u)) >> 16; }
__device__ __forceinline__ unsigned pk2(float lo, float hi) { return f2bf(lo) | (f2bf(hi) << 16); }
template <int X> __device__ __forceinline__ float swz_xor(float v) { return __uint_as_float((unsigned)__builtin_amdgcn_ds_swizzle((int)__float_as_uint(v), (X << 10) | 0x1f)); }
__device__ __forceinline__ float wave_sum(float v) {
    v += swz_xor<1>(v); v += swz_xor<2>(v); v += swz_xor<4>(v); v += swz_xor<8>(v); v += swz_xor<16>(v);
    auto rr = __builtin_amdgcn_permlane32_swap(__float_as_uint(v), __float_as_uint(v), false, false); return __uint_as_float(rr[0]) + __uint_as_float(rr[1]);
}
__device__ __forceinline__ float sigmoidf_(float z) { return __builtin_amdgcn_rcpf(1.0f + __builtin_amdgcn_exp2f(z * -1.4426950408889634f)); }
__device__ __forceinline__ float siluf_(float z) { return z * __builtin_amdgcn_rcpf(1.0f + __builtin_amdgcn_exp2f(z * -1.4426950408889634f)); }
__device__ __forceinline__ void unpack8(const u32x4 w, float (&f)[8]) {
    f[0] = __uint_as_float(w.x << 16); f[1] = __uint_as_float(w.x & 0xffff0000u); f[2] = __uint_as_float(w.y << 16); f[3] = __uint_as_float(w.y & 0xffff0000u);
    f[4] = __uint_as_float(w.z << 16); f[5] = __uint_as_float(w.z & 0xffff0000u); f[6] = __uint_as_float(w.w << 16); f[7] = __uint_as_float(w.w & 0xffff0000u); }
__device__ __forceinline__ void ld8(const bf16* p, float (&f)[8]) { unpack8(*(const u32x4*)p, f); }

namespace pg8 {
template <bool I8> struct EpiProjT {
    static constexpr bool PERM = true, AFTER_DRAIN = false; static __device__ __forceinline__ bool keep(const Unit&) { return false; }
    bf16_t* T; const float* rope; const float* bias; const float* sa; const float* sb; int all8;
    static __device__ __forceinline__ f32x4 dq(const f32x4& a, float sr, const f32x4& sc) { if (!I8) return a; const i32x4 c = __builtin_bit_cast(i32x4, a); f32x4 r;
#pragma unroll
        for (int e = 0; e < 4; ++e) r[e] = (float)c[e] * (sr * sc[e]);
        return r; }
    __device__ __forceinline__ void operator()(const f32x4 (&acc)[2][2][4][2], const Unit& u, int wr, int wc, int fr, int fq) const {
        { const int l_ = mk_lane(); fr = l_ & 15; fq = l_ >> 4; }
        const int up = I8 ? (all8 ? INC / BM - 1 : NGATE / BM - 1) - u.pn : u.pn;
        const int pn = !I8 ? up + 32 : all8 ? (u.pn < 48 ? u.pn + 96 : (u.pn < 112 ? u.pn - 16 : u.pn - 112)) : (up < 32 ? up : up + 32);
        const int row0 = u.pm * BM + wr * 64 + fr, t = pn >> 3, colt = (pn & 7) * BM;
        bf16_t* base = T + (size_t)t * TE; const int col0 = colt + wc * 32 + 8 * fq;
        const int mode = (t < 2) ? (wc == 0 ? 1 : 0) : ((t >= 4 && t < 8) ? 4 : ((t == 3 || t == 11) ? 2 : (t >= 12 ? 3 : 0)));
        f32x4 sbv[2][2]; float sav[2][4];
#pragma unroll
        for (int bj = 0; bj < 2; ++bj)
#pragma unroll
            for (int n = 0; n < 2; ++n) sbv[bj][n] = I8 ? *(const f32x4*)(sb + u.pn * BM + wc * 32 + 8 * fq + bj * HALF + 4 * n) : (f32x4){1.f, 1.f, 1.f, 1.f};
#pragma unroll
        for (int ai = 0; ai < 2; ++ai)
#pragma unroll
            for (int m = 0; m < 4; ++m) sav[ai][m] = I8 ? sa[row0 + ai * HALF + m * 16] : 1.f;
        if (I8) { asm volatile("s_waitcnt vmcnt(0)" ::: "memory");
#pragma unroll
            for (int bj = 0; bj < 2; ++bj)
#pragma unroll
                for (int n = 0; n < 2; ++n) asm volatile("" : "+v"(sbv[bj][n])); }
#define ACCV(ai_, bj_, m_, n_) dq(acc[ai_][bj_][m_][n_], sav[ai_][m_], sbv[bj_][n_])
#define EPI_STORE8(rowp_, v0_, v1_) do { u32x4 w_; w_.x = cvt_pk_bf16((v0_)[0], (v0_)[1]); w_.y = cvt_pk_bf16((v0_)[2], (v0_)[3]); w_.z = cvt_pk_bf16((v1_)[0], (v1_)[1]); w_.w = cvt_pk_bf16((v1_)[2], (v1_)[3]); *(u32x4*)(rowp_) = w_; } while (0)
        if (mode == 1) {
            const float sg = (fq < 2) ? -1.f : 1.f; f32x4 csn[4];
            { const f32x4* tp = (const f32x4*)(rope + ((size_t)(row0 & (SEQ - 1)) * 16 + 8 * (fq & 1)) * 2); csn[0] = tp[0]; csn[1] = tp[1]; csn[2] = tp[2]; csn[3] = tp[3]; }
#pragma unroll
            for (int ai = 0; ai < 2; ++ai)
#pragma unroll
                for (int m = 0; m < 4; ++m) { const int row = row0 + ai * HALF + m * 16; bf16_t* rowp = base + (size_t)row * BW + col0;
                    f32x4 cs[2][2]; cs[0][0] = csn[0]; cs[0][1] = csn[1]; cs[1][0] = csn[2]; cs[1][1] = csn[3];
                    if (ai * 4 + m < 7) { const int rown = row0 + ((ai * 4 + m + 1) >> 2) * HALF + ((ai * 4 + m + 1) & 3) * 16;
                        const f32x4* tp = (const f32x4*)(rope + ((size_t)(rown & (SEQ - 1)) * 16 + 8 * (fq & 1)) * 2); csn[0] = tp[0]; csn[1] = tp[1]; csn[2] = tp[2]; csn[3] = tp[3]; }
#pragma unroll
                    for (int bj = 0; bj < 2; ++bj) { f32x4 v[2];
#pragma unroll
                        for (int n = 0; n < 2; ++n) { f32x4 a = ACCV(ai, bj, m, n); f32x4 p;
#pragma unroll
                            for (int e = 0; e < 4; ++e) { auto rr = __builtin_amdgcn_permlane32_swap(__float_as_uint(a[e]), __float_as_uint(a[e]), false, false); p[e] = __uint_as_float(fq >= 2 ? rr[0] : rr[1]); }
                            a[0] = a[0] * cs[n][0][0] + sg * p[0] * cs[n][0][1]; a[1] = a[1] * cs[n][0][2] + sg * p[1] * cs[n][0][3];
                            a[2] = a[2] * cs[n][1][0] + sg * p[2] * cs[n][1][1]; a[3] = a[3] * cs[n][1][2] + sg * p[3] * cs[n][1][3]; v[n] = a; }
                        EPI_STORE8(rowp + bj * HALF, v[0], v[1]); } }
        } else if (mode == 4) {
            bf16_t* dst = T + (size_t)((wc < 2) ? 5 : 4) * TE + (pn - 32) * 64 + 32 * (wc & 1) + 8 * fq;
#pragma unroll
            for (int ai = 0; ai < 2; ++ai)
#pragma unroll
                for (int m = 0; m < 4; ++m) { f32x4 v[2];
#pragma unroll
                    for (int n = 0; n < 2; ++n) { const f32x4 a = ACCV(ai, 0, m, n); f32x4 b = ACCV(ai, 1, m, n);
                        if (wc >= 2) { b[0] = siluf_(b[0]); b[1] = siluf_(b[1]); b[2] = siluf_(b[2]); b[3] = siluf_(b[3]); }
                        v[n] = a * b; }
                    EPI_STORE8(dst + (size_t)(row0 + ai * HALF + m * 16) * BW, v[0], v[1]); }
        } else if (mode == 2) {
#pragma unroll
            for (int ai = 0; ai < 2; ++ai)
#pragma unroll
                for (int m = 0; m < 4; ++m) { bf16_t* rowp = base + (size_t)(row0 + ai * HALF + m * 16) * BW + col0;
#pragma unroll
                    for (int bj = 0; bj < 2; ++bj) { f32x4 v[2];
#pragma unroll
                        for (int n = 0; n < 2; ++n) { f32x4 a = ACCV(ai, bj, m, n); a[0] = siluf_(a[0]); a[1] = siluf_(a[1]); a[2] = siluf_(a[2]); a[3] = siluf_(a[3]); v[n] = a; }
                        EPI_STORE8(rowp + bj * HALF, v[0], v[1]); } }
        } else if (mode == 3) {
            f32x4 bv[2][2];
#pragma unroll
            for (int bj = 0; bj < 2; ++bj)
#pragma unroll
                for (int n = 0; n < 2; ++n) bv[bj][n] = *(const f32x4*)(bias + (t - 12) * BW + col0 + bj * HALF + 4 * n);
#pragma unroll
            for (int ai = 0; ai < 2; ++ai)
#pragma unroll
                for (int m = 0; m < 4; ++m) { bf16_t* rowp = base + (size_t)(row0 + ai * HALF + m * 16) * BW + col0;
#pragma unroll
                    for (int bj = 0; bj < 2; ++bj) { f32x4 v[2];
#pragma unroll
                        for (int n = 0; n < 2; ++n) { f32x4 a = ACCV(ai, bj, m, n) + bv[bj][n]; a[0] = sigmoidf_(a[0]); a[1] = sigmoidf_(a[1]); a[2] = sigmoidf_(a[2]); a[3] = sigmoidf_(a[3]); v[n] = a; }
                        EPI_STORE8(rowp + bj * HALF, v[0], v[1]); } }
        } else {
#pragma unroll
            for (int ai = 0; ai < 2; ++ai)
#pragma unroll
                for (int m = 0; m < 4; ++m) { bf16_t* rowp = base + (size_t)(row0 + ai * HALF + m * 16) * BW + col0;
#pragma unroll
                    for (int bj = 0; bj < 2; ++bj) { const f32x4 v0 = ACCV(ai, bj, m, 0), v1 = ACCV(ai, bj, m, 1); EPI_STORE8(rowp + bj * HALF, v0, v1); } }
        }
#undef EPI_STORE8
#undef ACCV
    }
};
struct EpiBranch {
    static constexpr bool PERM = true, AFTER_DRAIN = false; static __device__ __forceinline__ bool keep(const Unit& u) { return (u.pm >> 5) < 2; }
    const bf16_t* G6; bf16_t* Y;
    __device__ __forceinline__ void operator()(f32x4 (&acc)[2][2][4][2], const Unit& u, int wr, int wc, int fr, int fq) const {
        const int br = u.pm >> 5, pm = u.pm & 31, pn = u.pn & 15;
        const int row0 = pm * BM + wr * 64 + fr, col0 = pn * BM + wc * 32 + 8 * fq;
        const bf16_t* gb = G6 + (size_t)(2 * br + (pn >> 3)) * TE + (col0 & (BW - 1));
        if (br < 2) {
#pragma unroll
            for (int ai = 0; ai < 2; ++ai) { u32x4 gv[4][2], gnv[4][2];
#pragma unroll
                for (int m = 0; m < 4; ++m) { const size_t ro = (size_t)(row0 + ai * HALF + m * 16) * BW;
#pragma unroll
                    for (int bj = 0; bj < 2; ++bj) { gv[m][bj] = *(const u32x4*)(gb + ro + bj * HALF); gnv[m][bj] = *(const u32x4*)(gb + 2 * TE + ro + bj * HALF); } }
                asm volatile("s_waitcnt vmcnt(0)" ::: "memory");
#pragma unroll
                for (int m = 0; m < 4; ++m)
#pragma unroll
                    for (int bj = 0; bj < 2; ++bj) { float g[8], gn[8]; unpack8(gv[m][bj], g); unpack8(gnv[m][bj], gn);
#pragma unroll
                        for (int e = 0; e < 8; ++e) g[e] = fmaxf(g[e], 1e-30f) * __builtin_amdgcn_rcpf(fmaxf(gn[e], 1e-30f));
                        f32x4& v0 = acc[ai][bj][m][0]; f32x4& v1 = acc[ai][bj][m][1];
                        v0[0] *= g[0]; v0[1] *= g[1]; v0[2] *= g[2]; v0[3] *= g[3]; v1[0] *= g[4]; v1[1] *= g[5]; v1[2] *= g[6]; v1[3] *= g[7]; } }
        } else {
            u32x4 gv[2][4][2];
#pragma unroll
            for (int ai = 0; ai < 2; ++ai)
#pragma unroll
                for (int m = 0; m < 4; ++m)
#pragma unroll
                    for (int bj = 0; bj < 2; ++bj) gv[ai][m][bj] = *(const u32x4*)(gb + (size_t)(row0 + ai * HALF + m * 16) * BW + bj * HALF);
            asm volatile("s_waitcnt vmcnt(0)" ::: "memory");
#pragma unroll
            for (int ai = 0; ai < 2; ++ai)
#pragma unroll
                for (int m = 0; m < 4; ++m) { const int row = row0 + ai * HALF + m * 16;
#pragma unroll
                    for (int bj = 0; bj < 2; ++bj) { float g[8]; unpack8(gv[ai][m][bj], g);
#pragma unroll
                        for (int e = 0; e < 8; ++e) g[e] = fmaxf(g[e], 1e-30f);
                        const f32x4 v0 = acc[ai][bj][m][0], v1 = acc[ai][bj][m][1]; u32x4 w;
                        w.x = cvt_pk_bf16(v0[0] * g[0], v0[1] * g[1]); w.y = cvt_pk_bf16(v0[2] * g[2], v0[3] * g[3]); w.z = cvt_pk_bf16(v1[0] * g[4], v1[1] * g[5]); w.w = cvt_pk_bf16(v1[2] * g[6], v1[3] * g[7]);
                        *(u32x4*)(Y + (size_t)row * DM + col0 + bj * HALF) = w; } }
        }
    }
};
struct EpiBf16Plain {
    static constexpr bool PERM = true, AFTER_DRAIN = false; static __device__ __forceinline__ bool keep(const Unit&) { return false; }
    bf16_t* O; int ldc, pad;
    __device__ __forceinline__ void operator()(const f32x4 (&acc)[2][2][4][2], const Unit& u, int wr, int wc, int fr, int fq) const {
        const int row0 = u.pm * BM + wr * 64 + fr, col0 = u.pn * BM + wc * 32 + 8 * fq;
#pragma unroll
        for (int ai = 0; ai < 2; ++ai)
#pragma unroll
            for (int m = 0; m < 4; ++m) { bf16_t* rowp = O + (size_t)(row0 + ai * HALF + m * 16) * ldc + col0;
#pragma unroll
                for (int bj = 0; bj < 2; ++bj) { const f32x4 v0 = acc[ai][bj][m][0], v1 = acc[ai][bj][m][1]; u32x4 w;
                    w.x = cvt_pk_bf16(v0[0], v0[1]); w.y = cvt_pk_bf16(v0[2], v0[3]); w.z = cvt_pk_bf16(v1[0], v1[1]); w.w = cvt_pk_bf16(v1[2], v1[3]); *(u32x4*)(rowp + bj * HALF) = w; } }
    }
};
struct EpiOut8 {
    static constexpr bool PERM = true, AFTER_DRAIN = false; static __device__ __forceinline__ bool keep(const Unit&) { return false; }
    bf16_t* O; const float* sa; const float* sb;
    __device__ __forceinline__ void operator()(const f32x4 (&acc)[2][2][4][2], const Unit& u, int wr, int wc, int fr, int fq) const {
        { const int l_ = mk_lane(); fr = l_ & 15; fq = l_ >> 4; }
        const int row0 = u.pm * BM + wr * 64 + fr, col0 = u.pn * BM + wc * 32 + 8 * fq;
        f32x4 sbv[2][2]; float sav[2][4];
#pragma unroll
        for (int bj = 0; bj < 2; ++bj)
#pragma unroll
            for (int n = 0; n < 2; ++n) sbv[bj][n] = *(const f32x4*)(sb + col0 + bj * HALF + 4 * n);
#pragma unroll
        for (int ai = 0; ai < 2; ++ai)
#pragma unroll
            for (int m = 0; m < 4; ++m) sav[ai][m] = sa[row0 + ai * HALF + m * 16];
        asm volatile("s_waitcnt vmcnt(0)" ::: "memory");
#pragma unroll
        for (int bj = 0; bj < 2; ++bj)
#pragma unroll
            for (int n = 0; n < 2; ++n) asm volatile("" : "+v"(sbv[bj][n]));
#pragma unroll
        for (int ai = 0; ai < 2; ++ai)
#pragma unroll
            for (int m = 0; m < 4; ++m) { bf16_t* rowp = O + (size_t)(row0 + ai * HALF + m * 16) * DM + col0;
#pragma unroll
                for (int bj = 0; bj < 2; ++bj) { const f32x4 v0 = EpiProjT<true>::dq(acc[ai][bj][m][0], sav[ai][m], sbv[bj][0]), v1 = EpiProjT<true>::dq(acc[ai][bj][m][1], sav[ai][m], sbv[bj][1]); u32x4 w;
                    w.x = cvt_pk_bf16(v0[0], v0[1]); w.y = cvt_pk_bf16(v0[2], v0[3]); w.z = cvt_pk_bf16(v1[0], v1[1]); w.w = cvt_pk_bf16(v1[2], v1[3]); *(u32x4*)(rowp + bj * HALF) = w; } }
    }
};
struct BranchOrder {
    StaticOrder base;
    __device__ void init(int G_, int c_) { base.init(M, DM, G_, c_); }
    __device__ bool next(int i, Unit& u) const { const int tile = i / 3, br = i - 3 * tile; Unit v; if (!base.next(tile, v)) return false; u.pm = v.pm + 32 * br; u.pn = v.pn + 16 * br; return true; }
    __device__ __forceinline__ void a_ready(const Unit&) const {}
    __device__ __forceinline__ void done(const Unit&) const {}
};
struct ProjOrder {
    StaticOrder base; const bf16_t* Tk; bf16_t* KM; PG8_LAS float* red; int all8, wave;
    __device__ void init(int M_, int N_, int G_, int c_, const bf16_t* Tk_, bf16_t* KM_, PG8_LAS float* red_, int all8_, int wave_) { base.init(M_, N_, G_, c_); Tk = Tk_; KM = KM_; red = red_; all8 = all8_; wave = wave_; }
    __device__ bool next(int i, Unit& u) const { return base.next(i, u); }
    __device__ __forceinline__ void a_ready(const Unit&) const {}
    __device__ __forceinline__ void done(const Unit& u) const {
        const int up = NGATE / BM - 1 - u.pn, o = all8 ? (u.pn < 48 ? u.pn + 96 : (u.pn < 112 ? u.pn - 16 : u.pn - 112)) : (up < 32 ? up : up + 32);
        if (o < 8 || o >= 16) return;
        asm volatile("s_waitcnt vmcnt(0)" ::: "memory"); __syncthreads();
        const int lane = mk_lane(), c8 = o - 8, b = u.pm >> 4, j = u.pm & 15;
        const bf16_t* kp = Tk + (size_t)(u.pm * BM + wave * 32) * 2048 + c8 * 256 + 4 * lane; float a4[4] = {0.f, 0.f, 0.f, 0.f};
#pragma unroll
        for (int h = 0; h < 2; ++h) { u32x2 v[16];
#pragma unroll
            for (int r = 0; r < 16; ++r) v[r] = *(const u32x2*)(kp + (size_t)(16 * h + r) * 2048);
#pragma unroll
            for (int r = 0; r < 16; ++r) { a4[0] += __uint_as_float(v[r].x << 16); a4[1] += __uint_as_float(v[r].x & 0xffff0000u); a4[2] += __uint_as_float(v[r].y << 16); a4[3] += __uint_as_float(v[r].y & 0xffff0000u); } }
#pragma unroll
        for (int e = 0; e < 4; ++e) red[wave * 256 + 4 * lane + e] = a4[e];
        __syncthreads();
        const int tid = wave * 64 + lane;
        if (tid < 256) { float t = 0.f;
#pragma unroll
            for (int w8 = 0; w8 < 8; ++w8) t += red[w8 * 256 + tid];
            const float km = t * (1.0f / 256.0f); const unsigned kh = (__float_as_uint(km) + 0x7fffu + ((__float_as_uint(km) >> 16) & 1u)) >> 16; const float kl = km - __uint_as_float(kh << 16);
            const unsigned klb = (__float_as_uint(kl) + 0x7fffu + ((__float_as_uint(kl) >> 16) & 1u)) >> 16;
            const int bh = b * 16 + 2 * c8 + (tid >> 7), d = tid & 127;
            KM[((size_t)bh * 32 + j) * 128 + d] = (bf16_t)kh; KM[((size_t)bh * 32 + 16 + j) * 128 + d] = (bf16_t)klb; }
    }
};
}

__device__ __forceinline__ float wave_max(float v) {
    v = fmaxf(v, swz_xor<1>(v)); v = fmaxf(v, swz_xor<2>(v)); v = fmaxf(v, swz_xor<4>(v)); v = fmaxf(v, swz_xor<8>(v)); v = fmaxf(v, swz_xor<16>(v));
    auto rr = __builtin_amdgcn_permlane32_swap(__float_as_uint(v), __float_as_uint(v), false, false); return fmaxf(__uint_as_float(rr[0]), __uint_as_float(rr[1]));
}
__device__ __forceinline__ unsigned q8(float v, float sc) { const float q = fminf(fmaxf(__builtin_rintf(v * sc), -127.f), 127.f); return (unsigned)(int)q & 0xffu; }
__device__ __forceinline__ unsigned q8x4(float a, float b, float c, float d, float sc) { return q8(a, sc) | (q8(b, sc) << 8) | (q8(c, sc) << 16) | (q8(d, sc) << 24); }
__device__ __forceinline__ int remap_conv_col(int n) { if (n < 4 * BW || n >= 8 * BW) return n; const int t = n >> 11, ch = n & (BW - 1), slot = (t == 5) ? 0 : (t == 4) ? 1 : (t == 6) ? 2 : 3; return 4 * BW + (ch >> 6) * 256 + slot * 64 + (ch & 63); }
__device__ __forceinline__ void quant_block(const float* W, int N, int ns, unsigned char* W8, float* sb, LAS unsigned char* Lb, int wave, int lane) {
    LAS float* scr = (LAS float*)(Lb + wave * 16384); LAS float* cmw = (LAS float*)(Lb + 12288);
    f32x4 m = {0.f, 0.f, 0.f, 0.f};
    for (int sub = 0; sub < 8; ++sub) { const int k0 = 512 * wave + 64 * sub; f32x4 w[8];
#pragma unroll
        for (int i = 0; i < 8; ++i) w[i] = *(const f32x4*)(W + (size_t)(k0 + 8 * i + (lane >> 3)) * N + ns + (lane & 7) * 4);
#pragma unroll
        for (int i = 0; i < 8; ++i) m = __builtin_elementwise_max(m, __builtin_elementwise_abs(w[i])); }
#pragma unroll
    for (int e = 0; e < 4; ++e) { float t = m[e]; t = fmaxf(t, swz_xor<8>(t)); t = fmaxf(t, swz_xor<16>(t));
        auto rr = __builtin_amdgcn_permlane32_swap(__float_as_uint(t), __float_as_uint(t), false, false); t = fmaxf(__uint_as_float(rr[0]), __uint_as_float(rr[1]));
        if (lane < 8) cmw[wave * 32 + lane * 4 + e] = t; }
    __syncthreads();
    float sc[4];
#pragma unroll
    for (int j = 0; j < 4; ++j) { const int n = (lane >> 3) + 8 * j; float am = cmw[n];
#pragma unroll
        for (int w8 = 1; w8 < 8; ++w8) am = fmaxf(am, cmw[w8 * 32 + n]);
        sc[j] = am > 0.f ? 127.0f / am : 0.f; if (wave == 0 && (lane & 7) == 0) sb[n] = am * (1.0f / 127.0f); }
    const int c = lane & 7;
    for (int sub = 0; sub < 8; ++sub) { const int k0 = 512 * wave + 64 * sub; f32x4 w[8];
#pragma unroll
        for (int i = 0; i < 8; ++i) w[i] = *(const f32x4*)(W + (size_t)(k0 + 8 * i + (lane >> 3)) * N + ns + (lane & 7) * 4);
#pragma unroll
        for (int i = 0; i < 8; ++i) { LAS float* d = scr + (8 * i + (lane >> 3)) * 33 + (lane & 7) * 4; d[0] = w[i][0]; d[1] = w[i][1]; d[2] = w[i][2]; d[3] = w[i][3]; }
        asm volatile("s_waitcnt lgkmcnt(0)" ::: "memory");
#pragma unroll
        for (int j = 0; j < 4; ++j) { const int n = (lane >> 3) + 8 * j; const LAS float* sp = scr + (8 * c) * 33 + n;
            u32x2 o; o.x = q8x4(sp[0 * 33], sp[1 * 33], sp[2 * 33], sp[3 * 33], sc[j]); o.y = q8x4(sp[4 * 33], sp[5 * 33], sp[6 * 33], sp[7 * 33], sc[j]);
            *(u32x2*)(W8 + (size_t)n * DM + k0 + 8 * c) = o; }
        asm volatile("s_waitcnt lgkmcnt(0)" ::: "memory"); }
    __syncthreads();
}
template <bool REMAP = false>
__device__ __forceinline__ void transpose_item(const float* W, int K, int N, bf16* WT, LAS float* scr, int item, int lane) {
    const int nblk = N / 32, kb = item / nblk, nb = item % nblk, k0 = 64 * kb, n0 = 32 * nb, n0d = REMAP ? remap_conv_col(n0) : n0;
    f32x4 w[8];
#pragma unroll
    for (int i = 0; i < 8; ++i) w[i] = __builtin_nontemporal_load((const f32x4*)(W + (size_t)(k0 + 8 * i + (lane >> 3)) * N + n0 + (lane & 7) * 4));
#pragma unroll
    for (int i = 0; i < 8; ++i) { LAS float* d = scr + (8 * i + (lane >> 3)) * 33 + (lane & 7) * 4; d[0] = w[i][0]; d[1] = w[i][1]; d[2] = w[i][2]; d[3] = w[i][3]; }
    asm volatile("s_waitcnt lgkmcnt(0)" ::: "memory");
    const int c = lane & 7;
#pragma unroll
    for (int j = 0; j < 4; ++j) { const int n = (lane >> 3) + 8 * j; const LAS float* s = scr + (8 * c) * 33 + n;
        u32x4 o; o.x = pk2(s[0 * 33], s[1 * 33]); o.y = pk2(s[2 * 33], s[3 * 33]); o.z = pk2(s[4 * 33], s[5 * 33]); o.w = pk2(s[6 * 33], s[7 * 33]);
        *(u32x4*)(WT + (size_t)(n0d + n) * K + k0 + 8 * c) = o; }
    asm volatile("s_waitcnt lgkmcnt(0)" ::: "memory");
}
__device__ __forceinline__ void rope_entry(float2* tab, int idx) {
    const int pos = idx >> 4, i = idx & 15;
    const float inv = exp2f(-(float)i * (18.931568569324174f / 16.0f));
    const float ang = (float)pos * inv;
    const double a = (double)ang; const double kq = __builtin_rint(a * 0.63661977236758134308);
    const double r = (a - kq * 1.5707963267948966192) - kq * 6.123233995736766e-17; const double r2 = r * r;
    const double sr = r * (1.0 + r2 * (-1.0 / 6 + r2 * (1.0 / 120 + r2 * (-1.0 / 5040 + r2 * (1.0 / 362880 + r2 * (-1.0 / 39916800 + r2 * (1.0 / 6227020800.0)))))));
    const double cr = 1.0 + r2 * (-0.5 + r2 * (1.0 / 24 + r2 * (-1.0 / 720 + r2 * (1.0 / 40320 + r2 * (-1.0 / 3628800 + r2 * (1.0 / 479001600.0 + r2 * (-1.0 / 87178291200.0)))))));
    const int q = ((int)kq) & 3; double s, c;
    if (q == 0) { s = sr; c = cr; } else if (q == 1) { s = cr; c = -sr; } else if (q == 2) { s = -sr; c = -cr; } else { s = -cr; c = sr; }
    tab[idx] = make_float2((float)c, (float)s);
}
__device__ __forceinline__ void rmsnorm_row_bf16(const float* xrow, const float* g, bf16* orow, unsigned char* o8row, float* sa, int lane) {
    const f32x4* xr = (const f32x4*)xrow + lane; f32x4 v[16]; float s = 0.f;
#pragma unroll
    for (int j = 0; j < 16; ++j) { v[j] = xr[64 * j]; s += (v[j].x * v[j].x + v[j].y * v[j].y) + (v[j].z * v[j].z + v[j].w * v[j].w); }
    const float rs = 1.0f / sqrtf(wave_sum(s) * (1.0f / DM) + RMS_EPS);
    u32x2* o = (u32x2*)orow + lane; float am = 0.f;
#pragma unroll
    for (int j = 0; j < 16; ++j) { const f32x4 gv = ((const f32x4*)g)[lane + 64 * j]; v[j] = v[j] * rs * gv; u32x2 w; w.x = pk2(v[j].x, v[j].y); w.y = pk2(v[j].z, v[j].w); o[64 * j] = w;
        am = fmaxf(am, fmaxf(fmaxf(fabsf(v[j].x), fabsf(v[j].y)), fmaxf(fabsf(v[j].z), fabsf(v[j].w)))); }
    am = wave_max(am); const float sc = am > 0.f ? 127.0f / am : 0.f; unsigned* o8 = (unsigned*)o8row + lane;
#pragma unroll
    for (int j = 0; j < 16; ++j) o8[64 * j] = q8x4(v[j].x, v[j].y, v[j].z, v[j].w, sc);
    if (lane == 0) *sa = am * (1.0f / 127.0f);
}
__device__ __forceinline__ void yq_row(const bf16* yrow, unsigned char* y8row, float* sa, int lane) {
    float v[8][8]; float am = 0.f;
#pragma unroll
    for (int j = 0; j < 8; ++j) { ld8(yrow + 8 * lane + 512 * j, v[j]);
#pragma unroll
        for (int e = 0; e < 8; ++e) am = fmaxf(am, fabsf(v[j][e])); }
    am = wave_max(am); const float sc = am > 0.f ? 127.0f / am : 0.f;
#pragma unroll
    for (int j = 0; j < 8; ++j) { u32x2 q; q.x = q8x4(v[j][0], v[j][1], v[j][2], v[j][3], sc); q.y = q8x4(v[j][4], v[j][5], v[j][6], v[j][7], sc); *(u32x2*)(y8row + 8 * lane + 512 * j) = q; }
    if (lane == 0) *sa = am * (1.0f / 127.0f);
}
template <bool XIN_BF16, bool XOUT_BF16>
__device__ __forceinline__ void final_row(const void* xrow_, const bf16* orow, const float* gpost, void* xnrow_, const float* gnext, bf16* hrow, unsigned char* h8row, float* sa, int lane) {
    float v[8][8]; float s = 0.f;
#pragma unroll
    for (int j = 0; j < 8; ++j) { ld8(orow + 8 * lane + 512 * j, v[j]);
#pragma unroll
        for (int e = 0; e < 8; ++e) s += v[j][e] * v[j][e]; }
    const float rs = 1.0f / sqrtf(wave_sum(s) * (1.0f / DM) + RMS_EPS); float s2 = 0.f;
#pragma unroll
    for (int j = 0; j < 8; ++j) { const int e0 = 8 * lane + 512 * j; const f32x4 g0 = *(const f32x4*)(gpost + e0), g1 = *(const f32x4*)(gpost + e0 + 4); float xv[8];
        if (XIN_BF16) ld8((const bf16*)xrow_ + e0, xv); else { const f32x4 x0 = *(const f32x4*)((const float*)xrow_ + e0), x1 = *(const f32x4*)((const float*)xrow_ + e0 + 4);
#pragma unroll
            for (int e = 0; e < 4; ++e) { xv[e] = x0[e]; xv[4 + e] = x1[e]; } }
#pragma unroll
        for (int e = 0; e < 8; ++e) { const float r = xv[e] + v[j][e] * rs * (e < 4 ? g0[e & 3] : g1[e & 3]); v[j][e] = r; s2 += r * r; }
        if (XOUT_BF16) { u32x4 w; w.x = pk2(v[j][0], v[j][1]); w.y = pk2(v[j][2], v[j][3]); w.z = pk2(v[j][4], v[j][5]); w.w = pk2(v[j][6], v[j][7]); *(u32x4*)((bf16*)xnrow_ + e0) = w; }
        else { *(f32x4*)((float*)xnrow_ + e0) = (f32x4){v[j][0], v[j][1], v[j][2], v[j][3]}; *(f32x4*)((float*)xnrow_ + e0 + 4) = (f32x4){v[j][4], v[j][5], v[j][6], v[j][7]}; } }
    if (gnext) { const float rs2 = 1.0f / sqrtf(wave_sum(s2) * (1.0f / DM) + RMS_EPS); float am = 0.f;
#pragma unroll
        for (int j = 0; j < 8; ++j) { const int e0 = 8 * lane + 512 * j; const f32x4 g0 = *(const f32x4*)(gnext + e0), g1 = *(const f32x4*)(gnext + e0 + 4); u32x4 w;
#pragma unroll
            for (int e = 0; e < 8; ++e) { v[j][e] = v[j][e] * rs2 * (e < 4 ? g0[e & 3] : g1[e & 3]); am = fmaxf(am, fabsf(v[j][e])); }
            w.x = pk2(v[j][0], v[j][1]); w.y = pk2(v[j][2], v[j][3]); w.z = pk2(v[j][4], v[j][5]); w.w = pk2(v[j][6], v[j][7]);
            if (hrow) *(u32x4*)(hrow + e0) = w; }
        am = wave_max(am); const float sc = am > 0.f ? 127.0f / am : 0.f;
#pragma unroll
        for (int j = 0; j < 8; ++j) { u32x2 q; q.x = q8x4(v[j][0], v[j][1], v[j][2], v[j][3], sc); q.y = q8x4(v[j][4], v[j][5], v[j][6], v[j][7], sc); *(u32x2*)(h8row + 8 * lane + 512 * j) = q; }
        if (lane == 0) *sa = am * (1.0f / 127.0f); }
}

namespace att {
typedef short bf16x8 __attribute__((ext_vector_type(8)));
typedef short s16x4 __attribute__((ext_vector_type(4)));
typedef float f32x16 __attribute__((ext_vector_type(16)));
constexpr int KVBLK = 64;
constexpr int SHM_V = KVBLK * HD * 2, SHM_K = KVBLK * HD * 2;
constexpr int OFF_V = 0, OFF_K = 2 * SHM_V, OFF_G = OFF_K + 2 * SHM_K, OFF_WS = OFF_G + 8192, OFF_Q = OFF_WS + NWAVES * 64 * 4, ATT_LDS = OFF_Q + NWAVES * 8192;
constexpr float C2 = ATT_SCALE * 1.4426950408889634f;
constexpr float THR = 8.f;
#ifndef ATT_SD_MOBA
#define ATT_SD_MOBA 1
#endif
#ifndef ATT_QLDS
#define ATT_QLDS 0
#endif
#ifndef ATT_SD_SB
#define ATT_SD_SB 1
#endif
#define KSWZ(row, colB) ((row) * 256 + ((colB) ^ (((row) & 7) << 4)))
#define SBAR() __builtin_amdgcn_sched_barrier(0)
__device__ __forceinline__ int crow(int r, int hi) { return (r & 3) + 8 * (r >> 2) + 4 * hi; }
__device__ __forceinline__ unsigned cvtpk(float lo, float hi) { return pg8::cvt_pk_bf16(lo, hi); }
__device__ __forceinline__ float swap_sum(float v) { auto rr = __builtin_amdgcn_permlane32_swap(__float_as_uint(v), __float_as_uint(v), false, false); return __uint_as_float(rr[0]) + __uint_as_float(rr[1]); }
__device__ __forceinline__ float swap_max(float v) { auto rr = __builtin_amdgcn_permlane32_swap(__float_as_uint(v), __float_as_uint(v), false, false); return fmaxf(__uint_as_float(rr[0]), __uint_as_float(rr[1])); }
__device__ __forceinline__ float swap_other(float v, int hi) { auto rr = __builtin_amdgcn_permlane32_swap(__float_as_uint(v), __float_as_uint(v), false, false); return __uint_as_float(hi ? rr[0] : rr[1]); }
__device__ __forceinline__ void qkt(f32x16& p0, f32x16& p1, const LAS char* Ks, const bf16x8* qr, int r32, int hi) {
    p0 = f32x16{}; p1 = f32x16{};
#pragma unroll
    for (int d0 = 0; d0 < 8; ++d0) { const int cb = (d0 * 16 + hi * 8) * 2;
        const bf16x8 b0 = *(const LAS bf16x8*)(Ks + KSWZ(r32, cb)); const bf16x8 b1 = *(const LAS bf16x8*)(Ks + KSWZ(32 + r32, cb));
        p0 = __builtin_amdgcn_mfma_f32_32x32x16_bf16(b0, qr[d0], p0, 0, 0, 0);
        p1 = __builtin_amdgcn_mfma_f32_32x32x16_bf16(b1, qr[d0], p1, 0, 0, 0); }
}
__device__ __forceinline__ void qkt_l(f32x16& p0, f32x16& p1, const LAS char* Ks, const LAS char* Qs, int r32, int hi) {
    p0 = f32x16{}; p1 = f32x16{};
#pragma unroll
    for (int d0 = 0; d0 < 8; ++d0) { const int cb = (d0 * 16 + hi * 8) * 2;
        const bf16x8 b0 = *(const LAS bf16x8*)(Ks + KSWZ(r32, cb)); const bf16x8 b1 = *(const LAS bf16x8*)(Ks + KSWZ(32 + r32, cb)); const bf16x8 q = *(const LAS bf16x8*)(Qs + d0 * 1024);
        p0 = __builtin_amdgcn_mfma_f32_32x32x16_bf16(b0, q, p0, 0, 0, 0);
        p1 = __builtin_amdgcn_mfma_f32_32x32x16_bf16(b1, q, p1, 0, 0, 0); }
}
__device__ __forceinline__ void qkt32(f32x16& p0, const LAS char* Ks, const bf16x8* qr, int r32, int hi) {
    p0 = f32x16{};
#pragma unroll
    for (int d0 = 0; d0 < 8; ++d0) { const int cb = (d0 * 16 + hi * 8) * 2;
        const bf16x8 b0 = *(const LAS bf16x8*)(Ks + KSWZ(r32, cb)); p0 = __builtin_amdgcn_mfma_f32_32x32x16_bf16(b0, qr[d0], p0, 0, 0, 0); }
}
__device__ __forceinline__ int v_st(int k, int c) { const int kk = (k & ~0xC) | ((k & 4) << 1) | ((k & 8) >> 1); return ((kk >> 3) * 4 + (c >> 5)) * 512 + ((kk & 7) * 32 + (c & 31)) * 2; }
__device__ __forceinline__ int v_rd_base(int lane) { return ((lane & 3) << 3) | (((lane >> 2) & 3) << 6) | (((lane >> 4) & 1) << 5) | (((lane >> 5) & 1) << 8); }
constexpr int v_rd_off(int d0, int ks, int half) { return d0 * 512 + ks * 4096 + half * 2048; }
template <int OFF> __device__ __forceinline__ s16x4 tr_read(int vb) { s16x4 r; asm volatile("ds_read_b64_tr_b16 %0, %1 offset:%2" : "=&v"(r) : "v"(vb), "i"(OFF) : "memory"); return r; }
template <int D0> __device__ __forceinline__ void pv_one(f32x16& od, int vb, bf16x8 pa0, bf16x8 pa1, bf16x8 pa2, bf16x8 pa3) {
    const s16x4 l0 = tr_read<v_rd_off(D0, 0, 0)>(vb), h0 = tr_read<v_rd_off(D0, 0, 1)>(vb), l1 = tr_read<v_rd_off(D0, 1, 0)>(vb), h1 = tr_read<v_rd_off(D0, 1, 1)>(vb);
    const s16x4 l2 = tr_read<v_rd_off(D0, 2, 0)>(vb), h2 = tr_read<v_rd_off(D0, 2, 1)>(vb), l3 = tr_read<v_rd_off(D0, 3, 0)>(vb), h3 = tr_read<v_rd_off(D0, 3, 1)>(vb);
    asm volatile("s_waitcnt lgkmcnt(0)" ::: "memory"); SBAR();
#define PK(Lo, Hi) (bf16x8){Lo[0], Lo[1], Lo[2], Lo[3], Hi[0], Hi[1], Hi[2], Hi[3]}
    od = __builtin_amdgcn_mfma_f32_32x32x16_bf16(pa0, PK(l0, h0), od, 0, 0, 0);
    od = __builtin_amdgcn_mfma_f32_32x32x16_bf16(pa1, PK(l1, h1), od, 0, 0, 0);
    od = __builtin_amdgcn_mfma_f32_32x32x16_bf16(pa2, PK(l2, h2), od, 0, 0, 0);
    od = __builtin_amdgcn_mfma_f32_32x32x16_bf16(pa3, PK(l3, h3), od, 0, 0, 0);
#undef PK
}
__device__ __forceinline__ void pv_d0(f32x16* o, int vb, bf16x8 pa0, bf16x8 pa1, bf16x8 pa2, bf16x8 pa3) {
    pv_one<0>(o[0], vb, pa0, pa1, pa2, pa3); pv_one<1>(o[1], vb, pa0, pa1, pa2, pa3); pv_one<2>(o[2], vb, pa0, pa1, pa2, pa3); pv_one<3>(o[3], vb, pa0, pa1, pa2, pa3);
}
__device__ __forceinline__ void pack_p(const f32x16& p0, const f32x16& p1, bf16x8& pa0, bf16x8& pa1, bf16x8& pa2, bf16x8& pa3) {
#define PK4(P, BASE, OUT) do { unsigned a0 = cvtpk(P[BASE + 0], P[BASE + 1]), a1 = cvtpk(P[BASE + 2], P[BASE + 3]);   \
    unsigned b0 = cvtpk(P[BASE + 4], P[BASE + 5]), b1 = cvtpk(P[BASE + 6], P[BASE + 7]);                              \
    auto r0 = __builtin_amdgcn_permlane32_swap(a0, b0, false, false); auto r1 = __builtin_amdgcn_permlane32_swap(a1, b1, false, false); \
    u32x4 w = {r0[0], r1[0], r0[1], r1[1]}; OUT = __builtin_bit_cast(bf16x8, w); } while (0)
    PK4(p0, 0, pa0); PK4(p0, 8, pa1); PK4(p1, 0, pa2); PK4(p1, 8, pa3);
#undef PK4
}
__device__ __forceinline__ void mask_neginf(f32x16& p0, f32x16& p1, int lim, int hi) {
#pragma unroll
    for (int r = 0; r < 16; ++r) { const int k = crow(r, hi); p0[r] = (k <= lim) ? p0[r] : -INFINITY; p1[r] = (k + 32 <= lim) ? p1[r] : -INFINITY; }
}
__device__ __forceinline__ void partialSM(f32x16& p0, f32x16& p1, float& m_reg, float& alpha, bool rowvalid) {
    float pmax = p0[0];
#pragma unroll
    for (int r = 1; r < 16; ++r) pmax = fmaxf(pmax, p0[r]);
#pragma unroll
    for (int r = 0; r < 16; ++r) pmax = fmaxf(pmax, p1[r]);
    pmax = swap_max(pmax); pmax = rowvalid ? pmax : -INFINITY;
    float mn;
    if (__builtin_expect(__all(pmax - m_reg <= THR / ATT_SCALE), 1)) { mn = m_reg; alpha = 1.f; }
    else { mn = fmaxf(m_reg, pmax); alpha = __builtin_amdgcn_exp2f((m_reg - mn) * C2); m_reg = mn; }
    const float mnC = rowvalid ? -mn * C2 : -INFINITY;
#pragma unroll
    for (int r = 0; r < 16; ++r) p0[r] = fmaf(p0[r], C2, mnC);
#pragma unroll
    for (int r = 0; r < 16; ++r) p1[r] = fmaf(p1[r], C2, mnC);
#pragma unroll
    for (int r = 0; r < 16; ++r) p0[r] = __builtin_amdgcn_exp2f(p0[r]);
}
__device__ __forceinline__ void finishSM(f32x16& p0, f32x16& p1, float alpha, float& l_reg, bf16x8& pa0, bf16x8& pa1, bf16x8& pa2, bf16x8& pa3) {
#pragma unroll
    for (int r = 0; r < 16; ++r) p1[r] = __builtin_amdgcn_exp2f(p1[r]);
    float ps = 0.f;
#pragma unroll
    for (int r = 0; r < 16; ++r) ps += p0[r];
#pragma unroll
    for (int r = 0; r < 16; ++r) ps += p1[r];
    ps = swap_sum(ps);
    l_reg = l_reg * alpha + ps;
    pack_p(p0, p1, pa0, pa1, pa2, pa3);
}
template <bool MASK> __device__ __forceinline__ void sb_part1(f32x16& p0, f32x16& p1, float (&S)[8], int lim, int hi) {
#pragma unroll
    for (int g = 0; g < 8; ++g) { float ls[4], lk[4];
#pragma unroll
        for (int i = 0; i < 4; ++i) { const int r = 4 * (g & 3) + i; const float s = (g < 4) ? p0[r] : p1[r];
            const float z2 = s * C2; const float t2 = __builtin_amdgcn_logf(1.0f + __builtin_amdgcn_exp2f(-fabsf(z2)));
            float a = fminf(z2, 0.f) - t2, b = a - z2;
            if (MASK) { const bool keep = (8 * g + 4 * hi + i) <= lim; a = keep ? a : -INFINITY; b = keep ? b : 0.f; }
            ls[i] = a; lk[i] = b; }
        const float s2 = lk[3], s1 = s2 + lk[2], s0 = s1 + lk[1]; S[g] = s0 + lk[0];
        const float e0 = ls[0] + s0, e1 = ls[1] + s1, e2 = ls[2] + s2, e3 = ls[3];
        if (g < 4) { p0[4 * g] = e0; p0[4 * g + 1] = e1; p0[4 * g + 2] = e2; p0[4 * g + 3] = e3; } else { p1[4 * (g - 4)] = e0; p1[4 * (g - 4) + 1] = e1; p1[4 * (g - 4) + 2] = e2; p1[4 * (g - 4) + 3] = e3; } }
}
__device__ __forceinline__ void sb_part2(f32x16& p0, f32x16& p1, const float (&S)[8], float& carry, int hi, bf16x8& pa0, bf16x8& pa1, bf16x8& pa2, bf16x8& pa3) {
    float U[8], T[8];
#pragma unroll
    for (int g = 0; g < 8; ++g) { auto rr = __builtin_amdgcn_permlane32_swap(__float_as_uint(S[g]), __float_as_uint(S[g]), false, false);
        const float x0 = __uint_as_float(rr[0]), x1 = __uint_as_float(rr[1]); U[g] = x0 + x1; T[g] = hi ? x0 : x1; }
    float W = 0.f;
#pragma unroll
    for (int g = 7; g >= 0; --g) { const float base = carry + W + (hi ? 0.f : T[g]);
#pragma unroll
        for (int i = 0; i < 4; ++i) { if (g < 4) p0[4 * g + i] = __builtin_amdgcn_exp2f(p0[4 * g + i] + base); else p1[4 * (g - 4) + i] = __builtin_amdgcn_exp2f(p1[4 * (g - 4) + i] + base); }
        W += U[g]; }
    carry += W;
    pack_p(p0, p1, pa0, pa1, pa2, pa3);
}

__device__ __forceinline__ void store_o_tile(const f32x16* o, const float* sc16, const bf16* Zp, bf16* Op, size_t gbase  , LAS char* lds, int wid, int lane, int r32, int hi) {
    LAS float* ost = (LAS float*)(lds + wid * (32 * 68 * 4)); const int row = lane >> 1, half = lane & 1;
#pragma unroll
    for (int p = 0; p < 2; ++p) {
#pragma unroll
        for (int dd = 0; dd < 2; ++dd)
#pragma unroll
            for (int r = 0; r < 16; ++r) ost[crow(r, hi) * 68 + 32 * dd + r32] = o[2 * p + dd][r] * sc16[r];
        asm volatile("s_waitcnt lgkmcnt(0)" ::: "memory");
        f32x4 v[8];
#pragma unroll
        for (int c = 0; c < 8; ++c) v[c] = *(const LAS f32x4*)(ost + row * 68 + half * 32 + 4 * c);
        const size_t ga = gbase + (size_t)row * BW + 64 * p + 32 * half;
        u32x4 zz[4];
#pragma unroll
        for (int c = 0; c < 4; ++c) zz[c] = *(const u32x4*)(Zp + ga + 8 * c);
        asm volatile("s_waitcnt lgkmcnt(0)" ::: "memory");
#pragma unroll
        for (int c = 0; c < 4; ++c) { float z[8]; unpack8(zz[c], z); const f32x4 a = v[2 * c], b = v[2 * c + 1]; u32x4 w;
            w.x = cvtpk(a[0] * z[0], a[1] * z[1]); w.y = cvtpk(a[2] * z[2], a[3] * z[3]); w.z = cvtpk(b[0] * z[4], b[1] * z[5]); w.w = cvtpk(b[2] * z[6], b[3] * z[7]);
            *(u32x4*)(Op + ga + 8 * c) = w; }
    }
}
struct MixTensors { const bf16* Q; const bf16* K; const bf16* V; const bf16* Z; bf16* O; };
template <int MODE>
__device__ __forceinline__ void mix_unit(const MixTensors& T, const bf16* KM, int b, int h, int qb, LAS char* lds, const int wave_s) {
    const int lane = mk_lane(), wid = wave_s, tid = wid * 64 + lane, r32 = lane & 31, hi = lane >> 5;
    LAS char* V_lds = lds + OFF_V; LAS char* K_lds = lds + OFF_K; LAS float* wsl = (LAS float*)(lds + OFF_WS) + wid * 64;
    const size_t rowbase = (size_t)b * SEQ; const int i0 = qb * 256, qrow = i0 + wid * 32 + r32;
    const bf16* Kh = T.K + rowbase * BW + h * HD; const bf16* Vh = T.V + rowbase * BW + h * HD;
    bf16x8 qr[8];
    { const bf16* Qw = T.Q + (rowbase + qrow) * BW + h * HD + hi * 8;
#pragma unroll
      for (int d0 = 0; d0 < 8; ++d0) qr[d0] = *(const bf16x8*)(Qw + d0 * 16); }
    const int sr = tid >> 4, sc = (tid & 15) * 8, vst0 = v_st(sr, sc), vst1 = v_st(32 + sr, sc);
    const int vb0 = (int)(unsigned)(uintptr_t)V_lds + v_rd_base(lane);
    const LAS char* Qs = lds + OFF_Q + wid * 8192 + lane * 16;
    if (ATT_QLDS) {
#pragma unroll
        for (int d0 = 0; d0 < 8; ++d0) *(LAS bf16x8*)(lds + OFF_Q + wid * 8192 + d0 * 1024 + lane * 16) = qr[d0]; }
#define QKT(P0, P1, KS) do { if (ATT_QLDS) qkt_l(P0, P1, KS, Qs, r32, hi); else qkt(P0, P1, KS, qr, r32, hi); } while (0)
    unsigned sel = 0;
    if (MODE == 0) {
        *(LAS bf16x8*)(lds + OFF_G + KSWZ(sr, sc * 2)) = *(const bf16x8*)(KM + (size_t)sr * HD + sc);
        __syncthreads();
        f32x16 gp; qkt32(gp, lds + OFF_G, qr, r32, hi);
        float g[16];
#pragma unroll
        for (int r = 0; r < 8; ++r) { const float own = gp[r] + gp[r + 8]; const float oth = swap_other(own, hi); const int jb = (r & 3) + 8 * (r >> 2);
            g[jb] = hi ? oth : own; g[jb + 4] = hi ? own : oth; }
#pragma unroll
        for (int j = 0; j < 16; ++j) g[j] = (j < qb) ? g[j] : -INFINITY;
#pragma unroll
        for (int pass = 0; pass < 3; ++pass) { float mx = g[0];
#pragma unroll
            for (int j = 1; j < 16; ++j) mx = fmaxf(mx, g[j]);
            int idx = 16;
#pragma unroll
            for (int j = 15; j >= 0; --j) idx = (g[j] == mx) ? j : idx;
            if (mx > -INFINITY) sel |= 1u << idx;
#pragma unroll
            for (int j = 0; j < 16; ++j) g[j] = (j == idx) ? -INFINITY : g[j]; }
    }
    constexpr int SD = MODE == 0 ? ATT_SD_MOBA : ATT_SD_SB, SE = 0, SO = SD - 1;
    struct { bf16x8 vs0, vs1, ks0, ks1; } st_[SD];
#define SLOAD(i, k0) do { st_[i].vs0 = *(const bf16x8*)(Vh + (size_t)((k0) + sr) * BW + sc); st_[i].vs1 = *(const bf16x8*)(Vh + (size_t)((k0) + 32 + sr) * BW + sc); \
    st_[i].ks0 = *(const bf16x8*)(Kh + (size_t)((k0) + sr) * BW + sc); st_[i].ks1 = *(const bf16x8*)(Kh + (size_t)((k0) + 32 + sr) * BW + sc); } while (0)
#define SWRITE(bf, i) do { *(LAS bf16x8*)(V_lds + (bf) * SHM_V + vst0) = st_[i].vs0; *(LAS bf16x8*)(V_lds + (bf) * SHM_V + vst1) = st_[i].vs1; \
    *(LAS bf16x8*)(K_lds + (bf) * SHM_K + KSWZ(sr, sc * 2)) = st_[i].ks0; *(LAS bf16x8*)(K_lds + (bf) * SHM_K + KSWZ(32 + sr, sc * 2)) = st_[i].ks1; } while (0)
#define SWAIT() do { if (SD == 2) asm volatile("s_waitcnt vmcnt(4)" ::: "memory"); else asm volatile("s_waitcnt vmcnt(0)" ::: "memory"); } while (0)
    const int NT = 4 * (qb + 1);
#define KEY0(j) (64 * (j))
    float m_reg = -1e30f, l_reg = 0.f, carry = 0.f; f32x16 o[4] = {};
    f32x16 pA0, pA1, pB0, pB1; float alA = 1.f, alB = 1.f, SA[8], SB[8]; bf16x8 pa0, pa1, pa2, pa3;
#define STEP1(P0, P1, AL, SS, j) do { const int key0 = KEY0(j); \
        if (MODE == 0) { bool rv = true; if (key0 >= i0) mask_neginf(P0, P1, qrow - key0, hi); else rv = (sel >> (key0 >> 8)) & 1u; partialSM(P0, P1, m_reg, AL, rv); } \
        else { if (key0 >= i0) sb_part1<true>(P0, P1, SS, qrow - key0 - 1, hi); else sb_part1<false>(P0, P1, SS, 0, hi); } } while (0)
#define STEP2(P0, P1, AL, SS) do { if (MODE == 0) finishSM(P0, P1, AL, l_reg, pa0, pa1, pa2, pa3); else sb_part2(P0, P1, SS, carry, hi, pa0, pa1, pa2, pa3); } while (0)
#define RESC(a) do { if (MODE == 0) { if (__any((a) < 1.f)) { if (hi == 0) wsl[32 + r32] = (a); asm volatile("s_waitcnt lgkmcnt(0)" ::: "memory"); \
        _Pragma("unroll") for (int d = 0; d < 4; ++d) _Pragma("unroll") for (int r = 0; r < 16; ++r) o[d][r] *= wsl[32 + crow(r, hi)]; } } } while (0)
    SLOAD(SE, KEY0(0)); asm volatile("s_waitcnt vmcnt(0)" ::: "memory"); SWRITE(0, SE); __syncthreads();
    QKT(pA0, pA1, K_lds); STEP1(pA0, pA1, alA, SA, 0);
    SLOAD(SO, KEY0(1)); if (SD == 2) SLOAD(SE, KEY0(2));
    SWAIT(); SWRITE(1, SO); __syncthreads();
    for (int j = 1; j + 1 < NT; j += 2) {
        SBAR(); QKT(pB0, pB1, K_lds + SHM_K);
        STEP2(pA0, pA1, alA, SA); SBAR();
        SLOAD(SO, KEY0(j + SD)); SBAR();
        pv_d0(o, vb0, pa0, pa1, pa2, pa3); STEP1(pB0, pB1, alB, SB, j);
        __syncthreads(); SWAIT(); SWRITE(0, SE);
        RESC(alB); __syncthreads();
        SBAR(); QKT(pA0, pA1, K_lds);
        STEP2(pB0, pB1, alB, SB); SBAR();
        SLOAD(SE, KEY0(j + 1 + SD < NT ? j + 1 + SD : j)); SBAR();
        pv_d0(o, vb0 + SHM_V, pa0, pa1, pa2, pa3); STEP1(pA0, pA1, alA, SA, j + 1);
        __syncthreads(); SWAIT(); SWRITE(1, SO);
        RESC(alA); __syncthreads();
    }
    SBAR(); QKT(pB0, pB1, K_lds + SHM_K);
    STEP2(pA0, pA1, alA, SA); SBAR();
    pv_d0(o, vb0, pa0, pa1, pa2, pa3); STEP1(pB0, pB1, alB, SB, NT - 1);
    __syncthreads(); RESC(alB);
    STEP2(pB0, pB1, alB, SB); SBAR();
    pv_d0(o, vb0 + SHM_V, pa0, pa1, pa2, pa3);
    asm volatile("s_waitcnt vmcnt(0)" ::: "memory");
    float rli[16];
    if (MODE == 0) { if (hi == 0) wsl[r32] = l_reg; asm volatile("s_waitcnt lgkmcnt(0)" ::: "memory");
#pragma unroll
        for (int r = 0; r < 16; ++r) rli[r] = __builtin_amdgcn_rcpf(wsl[crow(r, hi)]); }
    else {
#pragma unroll
        for (int r = 0; r < 16; ++r) rli[r] = 1.f; }
    __syncthreads();
    store_o_tile(o, rli, T.Z, T.O, (rowbase + i0 + wid * 32) * BW + h * HD, lds, wid, lane, r32, hi);
    __syncthreads();
#undef SLOAD
#undef SWRITE
#undef SWAIT
#undef KEY0
#undef STEP1
#undef STEP2
#undef RESC
#undef QKT
}

__device__ __forceinline__ void sb_unit(const MixTensors& T, int b, int h, int qb, LAS char* lds, const int wave_s) {
    const int lane = mk_lane(), wid = wave_s, tid = wid * 64 + lane, r32 = lane & 31, hi = lane >> 5;
    LAS char* V_lds = lds + OFF_V; LAS char* K_lds = lds + OFF_K; LAS int* dn = (LAS int*)(lds + OFF_WS);
    const size_t rowbase = (size_t)b * SEQ; const int i0 = qb * 256, qrow = i0 + wid * 32 + r32;
    const bf16* Kh = T.K + rowbase * BW + h * HD; const bf16* Vh = T.V + rowbase * BW + h * HD;
    bf16x8 qr[8];
    { const bf16* Qw = T.Q + (rowbase + qrow) * BW + h * HD + hi * 8;
#pragma unroll
      for (int d0 = 0; d0 < 8; ++d0) qr[d0] = *(const bf16x8*)(Qw + d0 * 16); }
    const int sr = tid >> 4, sc = (tid & 15) * 8, vst0 = v_st(sr, sc), vst1 = v_st(32 + sr, sc);
    const int vb0 = (int)(unsigned)(uintptr_t)V_lds + v_rd_base(lane);
    if (tid < 16) dn[tid] = 0;
    bf16x8 vs0, vs1, ks0, ks1;
#define SLOAD(k0) do { vs0 = *(const bf16x8*)(Vh + (size_t)((k0) + sr) * BW + sc); vs1 = *(const bf16x8*)(Vh + (size_t)((k0) + 32 + sr) * BW + sc); \
    ks0 = *(const bf16x8*)(Kh + (size_t)((k0) + sr) * BW + sc); ks1 = *(const bf16x8*)(Kh + (size_t)((k0) + 32 + sr) * BW + sc); } while (0)
#define SWRITE(bf) do { *(LAS bf16x8*)(V_lds + (bf) * SHM_V + vst0) = vs0; *(LAS bf16x8*)(V_lds + (bf) * SHM_V + vst1) = vs1; \
    *(LAS bf16x8*)(K_lds + (bf) * SHM_K + KSWZ(sr, sc * 2)) = ks0; *(LAS bf16x8*)(K_lds + (bf) * SHM_K + KSWZ(32 + sr, sc * 2)) = ks1; } while (0)
    const int NT = 4 * (qb + 1);
    float carry = 0.f; f32x16 o[4] = {}; bool wdone = false;
    SLOAD(64 * (NT - 1)); SWRITE(0); __syncthreads();
    for (int j = 0; j < NT; ++j) {
        const int bf = j & 1, key0 = 64 * (NT - 1 - j);
        if (j + 1 < NT) SLOAD(key0 - 64);
        if (!wdone && key0 < i0 + wid * 32 + 32) {
            f32x16 p0, p1; float S[8]; bf16x8 pa0, pa1, pa2, pa3;
            qkt(p0, p1, K_lds + bf * SHM_K, qr, r32, hi);
            if (key0 + 63 >= i0 + wid * 32) sb_part1<true>(p0, p1, S, qrow - key0 - 1, hi); else sb_part1<false>(p0, p1, S, 0, hi);
            sb_part2(p0, p1, S, carry, hi, pa0, pa1, pa2, pa3);
            pv_d0(o, vb0 + bf * SHM_V, pa0, pa1, pa2, pa3);
            wdone = __all(carry < -160.f);
        }
        if (lane == 0) dn[bf * 8 + wid] = wdone ? 1 : 0;
        if (j + 1 < NT) SWRITE(bf ^ 1);
        __syncthreads();
        if (__all(dn[bf * 8 + (lane & 7)] != 0)) break;
    }
    { float one16[16];
#pragma unroll
      for (int r = 0; r < 16; ++r) one16[r] = 1.f;
      store_o_tile(o, one16, T.Z, T.O, (rowbase + i0 + wid * 32) * BW + h * HD, lds, wid, lane, r32, hi); }
    __syncthreads();
#undef SLOAD
#undef SWRITE
}
#undef KSWZ
#undef SBAR
}

__device__ __forceinline__ void group_barrier(gu32* cnt, int local, unsigned* bar, int wave, unsigned target = 8u) {
    asm volatile("s_waitcnt vmcnt(0)" ::: "memory");
    __syncthreads();
    if (wave == 0) { if (mk_lane() == 0) {
        if (!local) { __builtin_amdgcn_fence(__ATOMIC_RELEASE, "agent"); asm volatile("s_waitcnt vmcnt(0)" ::: "memory"); }
        (void)xb_add((unsigned*)cnt, 1u);
        XB_SPIN(xb_ld((unsigned*)cnt) < target, bar);
        __builtin_amdgcn_fence(__ATOMIC_ACQUIRE, "agent"); asm volatile("s_waitcnt vmcnt(0)" ::: "memory"); } }
    __syncthreads();
}
struct Args { const float* in[10]; float* out; unsigned char* ws; int ph_lo, ph_hi; };
__global__ void __launch_bounds__(NWAVES * 64, 2) mk_fwd(Args args) {
    extern __shared__ __attribute__((aligned(16))) unsigned char lds[];
    LAS unsigned char* L = (LAS unsigned char*)lds;
    volatile LAS unsigned* MISC = (volatile LAS unsigned*)(L + MISC_OFF);
    const int wave_s = __builtin_amdgcn_readfirstlane(threadIdx.x >> 6);
    const int G = gridDim.x, NGW = G * NWAVES; const size_t NGT = (size_t)G * NWAVES * 64;
#define PHASE_IDS() const int lane = mk_lane(), wave = wave_s, tid = wave * 64 + lane, gw = blockIdx.x * NWAVES + wave; const size_t gt = (size_t)blockIdx.x * (NWAVES * 64) + tid; (void)lane; (void)gw; (void)gt
    unsigned char* ws = args.ws; gu32* ctl = (gu32*)(ws + WS_CTL);
    const float* x = args.in[0]; const float* pre_g = args.in[1]; const float* post_g = args.in[2]; const float* w_in = args.in[3]; const float* b_merge = args.in[4];
    const float* conv_w = args.in[5]; const float* w_out = args.in[9]; float* out = args.out;
    float2* rope = (float2*)(ws + WS_ROPE); bf16* KM = (bf16*)(ws + WS_KM); bf16* H = (bf16*)(ws + WS_H); bf16* T = (bf16*)(ws + WS_T); bf16* OBR = (bf16*)(ws + WS_OBR);
    bf16* Y = (bf16*)(ws + WS_Y); bf16* OUTB = (bf16*)(ws + WS_OUT); unsigned char* H8 = ws + WS_H8; float* SBv = (float*)(ws + WS_KMEAN); float* SAv = SBv + NGATE + INC; float* SBO = SAv + M; float* SAY = SBO + DM; unsigned char* Y8 = ws + WS_Y8;
    for (int u = threadIdx.x; u < (LDS_BYTES - RING_BYTES) / 4; u += NWAVES * 64) ((LAS unsigned*)(L + RING_BYTES))[u] = 0u;
    __syncthreads();
    XcdBarrier bar; bar.bar = (unsigned*)(ctl + CW_BAR); bar.x = 0; bar.st = nullptr;
    if (!MK_PER_PHASE) bar = xcd_barrier_post((unsigned*)(ctl + CW_BAR), MISC + 8);
    if (threadIdx.x == 0) __hip_atomic_store(ctl + CW_XID + blockIdx.x, xb_xcc_id() + 1u, RLX_AGENT);
#define GRID_BAR(seam) do { if (MK_PER_PHASE) { if (threadIdx.x == 0) __hip_atomic_store(ctl + CW_TMO, 0xBADBA0u | (unsigned)(seam), RLX_AGENT); } else { xcd_barrier(bar); } } while (0)
    const int lo = args.ph_lo, hi = args.ph_hi;
#define IN(k) (lo <= (k) && (k) < hi)
#define BOTH(k) (IN(k) && IN((k) + 1))

    if (IN(0)) { PHASE_IDS();
        LAS float* scr = (LAS float*)(L + wave * 16384);
        constexpr int I_IN = (DM / 64) * (NPROJ / 32), I_BR = (BW / 64) * (DM / 32), I_O = (DM / 64) * (DM / 32), I_L = 3 * I_BR, NB8 = NGATE / 32, NBA = INC / 32, NBO = DM / 32;
        for (;;) { LAS int* clm = (LAS int*)(L + 13312);
            if (tid == 0) *clm = (int)__hip_atomic_fetch_add(ctl + CW_QCLAIM, 1u, RLX_AGENT);
            __syncthreads(); const int cb = *clm; if (cb >= NB8 + NBA + NBO) break;
            if (cb < NB8) { const int n0 = 32 * cb, ns = n0 < 4 * BW ? n0 : n0 + 4 * BW;
                const int r8 = (NGATE / 256 - 1 - (n0 >> 8)) * 256 + (n0 & 255);
                quant_block(w_in, INC, ns, ws + WS_WIN + W8_OFF + (size_t)r8 * DM, SBv + r8, L, wave, lane); }
            else if (cb < NB8 + NBA) { const int n0 = 32 * (cb - NB8), nd = remap_conv_col(n0);
                const int o8 = nd >> 8, r8 = (o8 < 32 ? o8 + 112 : (o8 < 96 ? o8 + 16 : o8 - 96)) * 256 + (nd & 255);
                quant_block(w_in + (size_t)DM * INC, INC, n0, ws + WS_WIN + WIN_BYTES + W8_OFF + (size_t)r8 * DM, SBv + NGATE + r8, L, wave, lane); }
            else { const int n0 = 32 * (cb - NB8 - NBA);
                quant_block(w_out + (size_t)DM * DM, DM, n0, ws + WS_WO + WO_BYTES + (size_t)n0 * DM, SBO + n0, L, wave, lane); } }
        for (;;) { int c0 = 0; if (lane == 0) c0 = (int)__hip_atomic_fetch_add(ctl + CW_QCLAIM + 1, 1u, RLX_AGENT);
          c0 = __builtin_amdgcn_readfirstlane(c0) * 16; if (c0 >= I_IN + I_O + DEPTH * I_L) break;
          for (int it = c0; it < c0 + 16; ++it) {
            if (it < I_IN) { transpose_item<true>(w_in, DM, INC, (bf16*)(ws + WS_WIN), scr, (it / (NPROJ / 32)) * (INC / 32) + (4 * BW / 32) + it % (NPROJ / 32), lane); continue; }
            if (it < I_IN + I_O) { transpose_item(w_out, DM, DM, (bf16*)(ws + WS_WO), scr, it - I_IN, lane); continue; }
            const int Lr = (it - I_IN - I_O) / I_L, r = (it - I_IN - I_O) - Lr * I_L, i = r / I_BR;
            transpose_item((i == 0 ? args.in[6] : (i == 1 ? args.in[7] : args.in[8])) + (size_t)Lr * BW * DM, BW, DM, (bf16*)(ws + WS_WBR + Lr * WBR_BYTES) + (size_t)i * DM * BW, scr, r - i * I_BR, lane); } }
        for (size_t i = gt; i < (size_t)SEQ * 16; i += NGT) rope_entry(rope, (int)i);
        for (;;) { int m0 = 0; if (lane == 0) m0 = (int)__hip_atomic_fetch_add(ctl + CW_QCLAIM + 3, 1u, RLX_AGENT);
            m0 = __builtin_amdgcn_readfirstlane(m0) * 2; if (m0 >= M) break;
            for (int m = m0; m < m0 + 2; ++m) rmsnorm_row_bf16(x + (size_t)m * DM, pre_g, H + (size_t)m * DM, H8 + (size_t)m * DM, SAv + m, lane); }
        if (BOTH(0)) GRID_BAR(0);
    }
    int grp = 0, grp_local = 0, xcd_local = 0; const int gpm = 4 * ((int)blockIdx.x & 7) + (((int)blockIdx.x >> 3) & 3), gmi = (int)blockIdx.x >> 5;
    if (!MK_PER_PHASE && G == 256) { const unsigned my = xb_ld((unsigned*)(ctl + CW_XID + blockIdx.x)); int same = 1;
#pragma unroll
        for (int q = 0; q < 8; ++q) same &= (xb_ld((unsigned*)(ctl + CW_XID + (blockIdx.x & 7) + 8 * (((blockIdx.x >> 3) & 3) + 4 * q))) == my) ? 1 : 0;
        grp = 1; grp_local = __builtin_amdgcn_readfirstlane(same);
        int samex = 1;
        for (int q = 0; q < 32; ++q) samex &= (xb_ld((unsigned*)(ctl + CW_XID + (blockIdx.x & 7) + 8 * q)) == my) ? 1 : 0;
        xcd_local = __builtin_amdgcn_readfirstlane(samex); }
#define SEAM_BAR(gs_, seam_) do { if (grp) group_barrier(ctl + CW_GRP + ((gs_) * 32 + gpm) * 8, grp_local, (unsigned*)(ctl + CW_BAR), wave_s); else GRID_BAR(seam_); } while (0)
#define MY_ROWS(m_, ...) do { if (grp) { for (int i_ = 0; i_ < 4; ++i_) { const int m_ = 256 * gpm + 32 * gmi + 4 * wave + i_; __VA_ARGS__; } } else { for (int m_ = gw; m_ < M; m_ += NGW) { __VA_ARGS__; } } } while (0)
    for (int Lr = 0; Lr < DEPTH; ++Lr) {
        const int pb = 1 + Lr * PH_PER_LAYER; const float* xc = Lr == 0 ? x : out;
        if (IN(pb + 0)) {
            if (Lr == 0) { pg8::Gemm g{H, (const bf16*)(ws + WS_WIN) + (size_t)4 * BW * DM, M, NPROJ, DM, 0}; pg8::StaticOrder S; S.init(M, NPROJ, G, (int)blockIdx.x);
              pg8::EpiProjT<false> E{T, (const float*)rope, b_merge, SAv, SBv, 0};
              pg8::gemm_phase<pg8::EpiProjT<false>, pg8::StaticOrder, true, true>(L, g, S, E, wave_s); }
            { const int N8 = Lr == 0 ? NGATE : INC;
              pg8::Gemm g{(const bf16*)H8, (const bf16*)(ws + WS_WIN + Lr * WIN_BYTES + W8_OFF), M, N8, DM / 2, 0}; pg8::ProjOrder S; S.init(M, N8, G, (int)blockIdx.x, T + TE, KM, (LAS float*)(L + RING_BYTES), Lr != 0, wave_s);
              pg8::EpiProjT<true> E{T, (const float*)rope, b_merge + Lr * 3 * DM, SAv, SBv + Lr * NGATE, Lr != 0};
              pg8::gemm_phase<pg8::EpiProjT<true>, pg8::ProjOrder, true, true, true>(L, g, S, E, wave_s); }
            if (BOTH(pb + 0)) GRID_BAR(pb + 0);
        }
        if (IN(pb + 2)) {
            { const att::MixTensors TA{T + 0 * TE, T + 1 * TE, T + 2 * TE, T + 3 * TE, OBR + 0 * TE};
              for (int pi = blockIdx.x; pi < 256; pi += G) { const int bh = 4 * (pi & 7) + (pi >> 6), pr = (pi >> 3) & 7;
                  for (int u = 0; u < 2; ++u) att::mix_unit<0>(TA, KM + (size_t)bh * 32 * HD, bh >> 4, bh & 15, u ? pr : 15 - pr, (LAS char*)L, wave_s); } }
            { const att::MixTensors TC{T + 8 * TE, T + 9 * TE, T + 10 * TE, T + 11 * TE, OBR + 2 * TE};
              for (int pi = blockIdx.x; pi < 256; pi += G) { const int bh = 4 * (pi & 7) + (pi >> 6), pr = (pi >> 3) & 7;
                  for (int u = 0; u < 2; ++u) att::sb_unit(TC, bh >> 4, bh & 15, u ? pr : 15 - pr, (LAS char*)L, wave_s); } }
            { PHASE_IDS();
            const float* cw = conv_w + Lr * 3 * BW;
            for (int rb = blockIdx.x; rb < M / 32; rb += G) { const int R0 = rb * 32 + (tid >> 8) * 16, c = (tid & 255) * 8, t0 = R0 & (SEQ - 1);
                const f32x4 wa0 = *(const f32x4*)(cw + c), wa1 = *(const f32x4*)(cw + c + 4), wb0 = *(const f32x4*)(cw + BW + c), wb1 = *(const f32x4*)(cw + BW + c + 4), wc0 = *(const f32x4*)(cw + 2 * BW + c), wc1 = *(const f32x4*)(cw + 2 * BW + c + 4);
                const size_t base = (size_t)R0 * BW + c; float x1[8], x2[8];
                if (t0 != 0) { ld8(T + 5 * TE + base - BW, x1); ld8(T + 5 * TE + base - 2 * BW, x2); }
                else {
#pragma unroll
                    for (int e = 0; e < 8; ++e) { x1[e] = 0.f; x2[e] = 0.f; } }
#pragma unroll
                for (int h = 0; h < 2; ++h) { u32x4 gv[8], xv[8];
#pragma unroll
                    for (int r = 0; r < 8; ++r) { gv[r] = *(const u32x4*)(T + 4 * TE + base + (size_t)(8 * h + r) * BW); xv[r] = *(const u32x4*)(T + 5 * TE + base + (size_t)(8 * h + r) * BW); }
#pragma unroll
                    for (int r = 0; r < 8; ++r) { float gb[8], x0[8], o[8]; unpack8(gv[r], gb); unpack8(xv[r], x0);
#pragma unroll
                        for (int e = 0; e < 8; ++e) { const float w0 = e < 4 ? wa0[e & 3] : wa1[e & 3], w1 = e < 4 ? wb0[e & 3] : wb1[e & 3], w2 = e < 4 ? wc0[e & 3] : wc1[e & 3];
                            o[e] = gb[e] * (w0 * x2[e] + w1 * x1[e] + w2 * x0[e]); x2[e] = x1[e]; x1[e] = x0[e]; }
                        u32x4 w; w.x = pk2(o[0], o[1]); w.y = pk2(o[2], o[3]); w.z = pk2(o[4], o[5]); w.w = pk2(o[6], o[7]); *(u32x4*)(OBR + 1 * TE + base + (size_t)(8 * h + r) * BW) = w; } } }
            }
            if (BOTH(pb + 2)) GRID_BAR(pb + 2);
        }
        if (IN(pb + 3)) {
            pg8::Gemm g{OBR, (const bf16*)(ws + WS_WBR + Lr * WBR_BYTES), 3 * M, 3 * DM, BW, 0}; pg8::BranchOrder S; S.init(G, (int)blockIdx.x);
            pg8::EpiBranch E{T + 12 * TE, Y};
            pg8::gemm_phase<pg8::EpiBranch, pg8::BranchOrder, true, true>(L, g, S, E, wave_s);
            if (BOTH(pb + 3)) SEAM_BAR(3 * Lr + 0, pb + 3);
        }
        if (IN(pb + 4) && Lr == DEPTH - 1) { PHASE_IDS();
            MY_ROWS(m, yq_row(Y + (size_t)m * DM, Y8 + (size_t)m * DM, SAY + m, lane));
            if (BOTH(pb + 4)) SEAM_BAR(3 * Lr + 1, pb + 4);
        }
        if (IN(pb + 5)) {
            if (Lr < DEPTH - 1) { pg8::Gemm g{Y, (const bf16*)(ws + WS_WO + Lr * WO_BYTES), M, DM, DM, 0}; pg8::StaticOrder S; S.init(M, DM, G, (int)blockIdx.x);
                pg8::EpiBf16Plain E{OUTB, DM, 0};
                pg8::gemm_phase<pg8::EpiBf16Plain, pg8::StaticOrder, true, true>(L, g, S, E, wave_s); }
            else { pg8::Gemm g{(const bf16*)Y8, (const bf16*)(ws + WS_WO + Lr * WO_BYTES), M, DM, DM / 2, 0}; pg8::StaticOrder S; S.init(M, DM, G, (int)blockIdx.x);
                pg8::EpiOut8 E{OUTB, SAY, SBO};
                pg8::gemm_phase<pg8::EpiOut8, pg8::StaticOrder, true, true, true>(L, g, S, E, wave_s); }
            if (BOTH(pb + 5)) SEAM_BAR(Lr == 0 ? 1 : 5, pb + 5);
        }
        if (IN(pb + 6)) { PHASE_IDS();
            bf16* X1B = (bf16*)(ws + WS_X1);
            if (Lr + 1 < DEPTH) { MY_ROWS(m, final_row<false, true>(x + (size_t)m * DM, OUTB + (size_t)m * DM, post_g + Lr * DM, X1B + (size_t)m * DM, pre_g + (Lr + 1) * DM, (bf16*)nullptr  , H8 + (size_t)m * DM, SAv + m, lane)); }
            else { MY_ROWS(m, final_row<true, false>(X1B + (size_t)m * DM, OUTB + (size_t)m * DM, post_g + Lr * DM, out + (size_t)m * DM, nullptr, H + (size_t)m * DM, H8 + (size_t)m * DM, SAv + m, lane)); }
            if (BOTH(pb + 6)) { if (grp) group_barrier(ctl + CW_GRP + (2 * 32 + ((int)blockIdx.x & 7)) * 8, xcd_local, (unsigned*)(ctl + CW_BAR), wave_s, 32u); else GRID_BAR(pb + 6); }
        }
    }
#undef IN
#undef BOTH
}

extern "C" void kernel_launch(void* const* d_in, const int* in_sizes, int n_in, void* d_out, int out_size, void* d_ws, size_t ws_size, hipStream_t stream) {
    static int grid = 0;
    if (grid == 0) {
        if (n_in != 10 || in_sizes[0] != M * DM || out_size != M * DM || ws_size < WS_END) { fprintf(stderr, "kernel_launch: shape mismatch (n_in %d, in0 %d, out %d, ws %zu, need %zu)\n", n_in, n_in > 0 ? in_sizes[0] : -1, out_size, ws_size, (size_t)WS_END); grid = -1; return; }
        int dev = 0, cus = 0, per_cu = 0;
        if (hipGetDevice(&dev) != hipSuccess || hipDeviceGetAttribute(&cus, hipDeviceAttributeMultiprocessorCount, dev) != hipSuccess) { fprintf(stderr, "kernel_launch: device query failed\n"); grid = -1; return; }
        if (hipFuncSetAttribute((const void*)mk_fwd, hipFuncAttributeMaxDynamicSharedMemorySize, LDS_BYTES) != hipSuccess) { fprintf(stderr, "kernel_launch: hipFuncSetAttribute failed\n"); grid = -1; return; }
        if (hipOccupancyMaxActiveBlocksPerMultiprocessor(&per_cu, (const void*)mk_fwd, NWAVES * 64, LDS_BYTES) != hipSuccess || per_cu < 1) { fprintf(stderr, "kernel_launch: occupancy query says %d workgroups per CU\n", per_cu); }
        (void)hipGetLastError();
        grid = cus;
    }
    if (grid < 0) return;
    if (hipMemsetAsync((char*)d_ws + WS_CTL, 0, CTL_ZERO_BYTES, stream) != hipSuccess) { fprintf(stderr, "kernel_launch: memset failed\n"); return; }
    Args a{};
    for (int i = 0; i < 10; ++i) a.in[i] = (const float*)d_in[i];
    a.out = (float*)d_out; a.ws = (unsigned char*)d_ws;
#if MK_PER_PHASE
    for (int p = 0; p < N_PHASES; ++p) {
        a.ph_lo = p; a.ph_hi = p + 1; hipLaunchKernelGGL(mk_fwd, dim3(grid), dim3(NWAVES * 64), LDS_BYTES, stream, a); }
#else
    a.ph_lo = 0; a.ph_hi = N_PHASES; hipLaunchKernelGGL(mk_fwd, dim3(grid), dim3(NWAVES * 64), LDS_BYTES, stream, a);
#endif
    const hipError_t le = hipPeekAtLastError();
    if (le != hipSuccess) fprintf(stderr, "kernel_launch: launch failed: %s\n", hipGetErrorName(le));
}
```

```cpp
#include <hip/hip_runtime.h>
#include <cstdio>
#include <cstdint>
#define LAS __attribute__((address_space(3)))
#define GAS __attribute__((address_space(1)))
__device__ __forceinline__ int mk_lane() { int l; asm volatile("v_mbcnt_lo_u32_b32 %0, -1, 0\n\tv_mbcnt_hi_u32_b32 %0, -1, %0" : "=v"(l)); return l; }
namespace pg8 {
#define PG8_LAS __attribute__((address_space(3)))
typedef unsigned short bf16_t;
typedef short bf16x8 __attribute__((ext_vector_type(8)));
typedef float f32x4 __attribute__((ext_vector_type(4)));
typedef unsigned u32x4 __attribute__((ext_vector_type(4)));
typedef int i32x4 __attribute__((ext_vector_type(4)));
constexpr int BM = 256, BK = 64, HALF = 128, HTB = HALF * BK * 2  , STAGE_BYTES = 8 * HTB, NXCD = 8, WGM = 4;

__host__ __device__ __forceinline__ int lds_byte(int r, int c) { const int st = (r >> 4) * 2 + (c >> 5), rr = r & 15, cc = c & 31, ob = rr * 64 + cc * 2; return st * 1024 + (ob ^ (((ob >> 9) & 1) << 5)); }
__host__ __device__ __forceinline__ void stage_rc(int b, int& R, int& C) { const int st = b / 1024, sb = b % 1024, swz = sb ^ (((sb >> 9) & 1) << 5); R = (st >> 1) * 16 + swz / 64; C = (st & 1) * 32 + (swz % 64) / 2; }
__host__ __device__ __forceinline__ int perm32(int rho) { const int n = rho >> 4, i = rho & 15; return 8 * (i >> 2) + 4 * n + (i & 3); }

struct Unit { int pm, pn; };
struct Gemm { const bf16_t* A; const bf16_t* Bt; int M, N, K, pad; };

struct StaticOrder {
    int nM, nN, nwg, G, c;
    __host__ __device__ void init(int M, int N, int G_, int c_) { nM = M / BM; nN = N / BM; nwg = nM * nN; G = G_; c = c_; }
    __host__ __device__ bool next(int i, Unit& u) const {
        const long L = (long)i * G + c; if (L >= nwg) return false;
        int wgid = (int)L; { const int q = nwg / NXCD, r = nwg % NXCD, xcd = wgid % NXCD, off = wgid / NXCD; wgid = (xcd < r ? xcd * (q + 1) : r * (q + 1) + (xcd - r) * q) + off; }
        const int nig = WGM * nN, gid = wgid / nig, fm = gid * WGM, gsz = (nM - fm) < WGM ? (nM - fm) : WGM;
        u.pm = fm + ((wgid % nig) % gsz); u.pn = (wgid % nig) / gsz; return true;
    }
    __device__ __forceinline__ void a_ready(const Unit&) const {}
    __device__ __forceinline__ void done(const Unit&) const {}
};

typedef float f32x2_t __attribute__((ext_vector_type(2))); typedef __bf16 bf16x2_t __attribute__((ext_vector_type(2)));
__device__ __forceinline__ unsigned cvt_pk_bf16(float lo, float hi) { const f32x2_t v = {lo, hi}; const bf16x2_t b = __builtin_convertvector(v, bf16x2_t); return __builtin_bit_cast(unsigned, b); }
typedef float f32x2 __attribute__((ext_vector_type(2)));
#ifndef PG8_SPLIT
#define PG8_SPLIT 0
#endif
template <class Epi, class Sched, bool ALIGN_EPI = false, bool SP2 = false, bool I8 = false>
__device__ __forceinline__ void gemm_phase(PG8_LAS unsigned char* lds, const Gemm g, const Sched& S, const Epi& E, const int wave_s) {
    const int tid = wave_s * 64 + mk_lane(),
              wid = __builtin_amdgcn_readfirstlane(tid >> 6), lane = tid & 63, wr = wid >> 2, wc = wid & 3, fr = lane & 15, fq = lane >> 4;
    const int K = g.K, nt = K / BK;
    unsigned voffA[2], voffB[2];
#pragma unroll
    for (int i = 0; i < 2; ++i) { int R, C; stage_rc(tid * 16 + i * 8192, R, C); const int Rb = Epi::PERM ? ((R & ~31) + perm32(R & 31)) : R;
        voffA[i] = (unsigned)(R * K + C) * 2u; voffB[i] = (unsigned)(Rb * K + C) * 2u; }
    const size_t kstep = (size_t)(BK * 2);
    const size_t hstep = (size_t)HALF * K * 2;
    const size_t tstep = 2 * hstep;
    const unsigned ldsw = (unsigned)wid * 1024u;
    const int aoff = lds_byte(wr * 64 + fr, fq * 8), boff = lds_byte(wc * 32 + fr, fq * 8);
#define PG8_SA(b, h) (((b) * 2 + (h)) * HTB)
#define PG8_SB(b, h) ((4 + (b) * 2 + (h)) * HTB)
#define PG8_STAGE(bufoff, gbase, voff) do { _Pragma("unroll") for (int _i = 0; _i < 2; ++_i) \
        __builtin_amdgcn_global_load_lds((const unsigned*)((const char*)(gbase) + (voff)[_i]), (PG8_LAS unsigned*)(lds + (bufoff) + ldsw + _i * 8192), 16, 0, 0); } while (0)
#define PG8_LDA(dst, b, h) do { _Pragma("unroll") for (int m = 0; m < 4; ++m) _Pragma("unroll") for (int k = 0; k < 2; ++k) dst[m][k] = *(const PG8_LAS bf16x8*)(lds + PG8_SA(b, h) + aoff + m * 2048 + k * 1024); } while (0)
#define PG8_LDB(dst, b, h) do { _Pragma("unroll") for (int n = 0; n < 2; ++n) _Pragma("unroll") for (int k = 0; k < 2; ++k) dst[n][k] = *(const PG8_LAS bf16x8*)(lds + PG8_SB(b, h) + boff + n * 2048 + k * 1024); } while (0)
#define PG8_MMA(ai, bj, At, Bt) do { __builtin_amdgcn_s_setprio(1); _Pragma("unroll") for (int m = 0; m < 4; ++m) _Pragma("unroll") for (int n = 0; n < 2; ++n) _Pragma("unroll") for (int k = 0; k < 2; ++k) \
        { if constexpr (I8) acc[ai][bj][m][n] = __builtin_bit_cast(f32x4, __builtin_amdgcn_mfma_i32_16x16x64_i8(__builtin_bit_cast(i32x4, Bt[n][k]), __builtin_bit_cast(i32x4, At[m][k]), __builtin_bit_cast(i32x4, acc[ai][bj][m][n]), 0, 0, 0)); \
          else acc[ai][bj][m][n] = __builtin_amdgcn_mfma_f32_16x16x32_bf16(Bt[n][k], At[m][k], acc[ai][bj][m][n], 0, 0, 0); } __builtin_amdgcn_s_setprio(0); } while (0)
#define PG8_WAIT_V(n) asm volatile("s_waitcnt vmcnt(" #n ")" ::: "memory")
#define PG8_WAIT_L(n) asm volatile("s_waitcnt lgkmcnt(" #n ")" ::: "memory")
#define PG8_BAR __builtin_amdgcn_s_barrier()
#define PG8_SCHED __builtin_amdgcn_sched_barrier(0)
    Unit cur, nxt; int ui = 0;
    if (!S.next(0, cur)) return;
    f32x4 acc[2][2][4][2];
#pragma unroll
    for (int a = 0; a < 2; ++a)
#pragma unroll
        for (int b = 0; b < 2; ++b)
#pragma unroll
            for (int m = 0; m < 4; ++m)
#pragma unroll
                for (int n = 0; n < 2; ++n) acc[a][b][m][n] = (f32x4){0.f, 0.f, 0.f, 0.f};
    bf16x8 At[4][2], B0[2][2], B1[2][2];
    const char* cA = (const char*)g.A + (size_t)cur.pm * tstep; const char* cB = (const char*)g.Bt + (size_t)cur.pn * tstep;
    S.a_ready(cur);
    if constexpr (SP2) {
        PG8_STAGE(PG8_SB(0, 0), cB, voffB); PG8_STAGE(PG8_SB(0, 1), cB + hstep, voffB); PG8_STAGE(PG8_SA(0, 0), cA, voffA); PG8_STAGE(PG8_SA(0, 1), cA + hstep, voffA);
        if (wr == 1) PG8_BAR;
        PG8_WAIT_V(2); PG8_BAR;
        PG8_STAGE(PG8_SB(1, 0), cB + kstep, voffB); PG8_STAGE(PG8_SA(1, 0), cA + kstep, voffA); PG8_STAGE(PG8_SB(1, 1), cB + hstep + kstep, voffB);
        PG8_WAIT_V(6); PG8_BAR;
    } else {
        PG8_STAGE(PG8_SB(0, 0), cB, voffB); PG8_STAGE(PG8_SA(0, 0), cA, voffA); PG8_STAGE(PG8_SB(0, 1), cB + hstep, voffB); PG8_STAGE(PG8_SA(0, 1), cA + hstep, voffA);
        if (wr == 1) PG8_BAR;
        PG8_WAIT_V(4); PG8_BAR;
        PG8_STAGE(PG8_SB(1, 0), cB + kstep, voffB); PG8_STAGE(PG8_SA(1, 0), cA + kstep, voffA); PG8_STAGE(PG8_SB(1, 1), cB + hstep + kstep, voffB);
        PG8_WAIT_V(6); PG8_BAR;
    }
    for (;;) {
        const bool has_next = S.next(ui + 1, nxt);
        const char* nA = has_next ? (const char*)g.A + (size_t)nxt.pm * tstep : cA; const char* nB = has_next ? (const char*)g.Bt + (size_t)nxt.pn * tstep : cB;
        for (int t = 0; t < nt; t += 2) {
            const bool last = (t == nt - 2);
            const char* a1 = cA + (size_t)(t + 1) * kstep;
            const char* a2 = last ? nA : cA + (size_t)(t + 2) * kstep; const char* b2 = last ? nB : cB + (size_t)(t + 2) * kstep;
            const char* a3 = a2 + kstep; const char* b3 = b2 + kstep;
            if (last && has_next) S.a_ready(nxt);
            if constexpr (SP2) {
            PG8_LDB(B0, 0, 0); PG8_LDB(B1, 0, 1); PG8_SCHED; PG8_LDA(At, 0, 0); PG8_STAGE(PG8_SA(1, 1), a1 + hstep, voffA);
            PG8_WAIT_V(8); PG8_WAIT_L(0); PG8_BAR; PG8_MMA(0, 0, At, B0); PG8_MMA(0, 1, At, B1); PG8_BAR; PG8_SCHED;
#if PG8_SPLIT
            PG8_LDA(At, 0, 1); PG8_STAGE(PG8_SB(0, 0), b2, voffB); PG8_STAGE(PG8_SB(0, 1), b2 + hstep, voffB);
            PG8_WAIT_V(6); PG8_WAIT_L(0); PG8_BAR; PG8_MMA(1, 0, At, B0); PG8_SCHED; PG8_STAGE(PG8_SA(0, 0), a2, voffA); PG8_SCHED; PG8_MMA(1, 1, At, B1); PG8_BAR; PG8_SCHED;
#else
            PG8_LDA(At, 0, 1); PG8_STAGE(PG8_SB(0, 0), b2, voffB); PG8_STAGE(PG8_SB(0, 1), b2 + hstep, voffB); PG8_STAGE(PG8_SA(0, 0), a2, voffA);
            PG8_WAIT_V(8); PG8_WAIT_L(0); PG8_BAR; PG8_MMA(1, 0, At, B0); PG8_MMA(1, 1, At, B1); PG8_BAR; PG8_SCHED;
#endif
            PG8_LDB(B0, 1, 0); PG8_LDB(B1, 1, 1); PG8_SCHED; PG8_LDA(At, 1, 0); PG8_STAGE(PG8_SA(0, 1), a2 + hstep, voffA);
            PG8_WAIT_V(8); PG8_WAIT_L(0); PG8_BAR; PG8_MMA(0, 0, At, B0); PG8_MMA(0, 1, At, B1); PG8_BAR; PG8_SCHED;
#if PG8_SPLIT
            PG8_LDA(At, 1, 1); PG8_STAGE(PG8_SB(1, 0), b3, voffB); PG8_STAGE(PG8_SB(1, 1), b3 + hstep, voffB);
            PG8_WAIT_V(6); PG8_WAIT_L(0); PG8_BAR; PG8_MMA(1, 0, At, B0); PG8_SCHED; PG8_STAGE(PG8_SA(1, 0), a3, voffA); PG8_SCHED; PG8_MMA(1, 1, At, B1); PG8_BAR; PG8_SCHED;
#else
            PG8_LDA(At, 1, 1); PG8_STAGE(PG8_SB(1, 0), b3, voffB); PG8_STAGE(PG8_SB(1, 1), b3 + hstep, voffB); PG8_STAGE(PG8_SA(1, 0), a3, voffA);
            PG8_WAIT_V(8); PG8_WAIT_L(0); PG8_BAR; PG8_MMA(1, 0, At, B0); PG8_MMA(1, 1, At, B1); PG8_BAR; PG8_SCHED;
#endif
            } else {
            PG8_LDB(B0, 0, 0); PG8_SCHED; PG8_LDA(At, 0, 0); PG8_STAGE(PG8_SA(1, 1), a1 + hstep, voffA);
            PG8_WAIT_L(8); PG8_BAR; PG8_WAIT_L(0); PG8_MMA(0, 0, At, B0); PG8_BAR; PG8_SCHED;
            PG8_LDB(B1, 0, 1); PG8_STAGE(PG8_SB(0, 0), b2, voffB);
            PG8_BAR; PG8_WAIT_L(0); PG8_MMA(0, 1, At, B1); PG8_BAR;
            PG8_LDA(At, 0, 1); PG8_STAGE(PG8_SA(0, 0), a2, voffA);
            PG8_BAR; PG8_WAIT_L(0); PG8_MMA(1, 0, At, B0); PG8_BAR; PG8_SCHED;
            PG8_STAGE(PG8_SB(0, 1), b2 + hstep, voffB);
            PG8_WAIT_V(6); PG8_BAR; PG8_MMA(1, 1, At, B1); PG8_BAR;
            PG8_LDB(B0, 1, 0); PG8_SCHED; PG8_LDA(At, 1, 0); PG8_STAGE(PG8_SA(0, 1), a2 + hstep, voffA);
            PG8_WAIT_L(8); PG8_BAR; PG8_WAIT_L(0); PG8_MMA(0, 0, At, B0); PG8_BAR; PG8_SCHED;
            PG8_LDB(B1, 1, 1); PG8_STAGE(PG8_SB(1, 0), b3, voffB);
            PG8_BAR; PG8_WAIT_L(0); PG8_MMA(0, 1, At, B1); PG8_BAR;
            PG8_LDA(At, 1, 1); PG8_STAGE(PG8_SA(1, 0), a3, voffA);
            PG8_BAR; PG8_WAIT_L(0); PG8_MMA(1, 0, At, B0); PG8_BAR; PG8_SCHED;
            PG8_STAGE(PG8_SB(1, 1), b3 + hstep, voffB);
            PG8_WAIT_V(6); PG8_BAR; PG8_MMA(1, 1, At, B1); PG8_BAR;
            }
        }
        if constexpr (ALIGN_EPI) { if (wr == 0) PG8_BAR; }
        if constexpr (!Epi::AFTER_DRAIN) { E(acc, cur, wr, wc, fr, fq); S.done(cur); }
        if (!has_next) break;
        if (!Epi::keep(cur)) {
#pragma unroll
        for (int a = 0; a < 2; ++a)
#pragma unroll
            for (int b = 0; b < 2; ++b)
#pragma unroll
                for (int m = 0; m < 4; ++m)
#pragma unroll
                    for (int n = 0; n < 2; ++n) acc[a][b][m][n] = (f32x4){0.f, 0.f, 0.f, 0.f};
        }
        cur = nxt; cA = nA; cB = nB; ++ui;
        if constexpr (ALIGN_EPI) { if (wr == 1) PG8_BAR; }
    }
    PG8_WAIT_V(0);
    if constexpr (!ALIGN_EPI) { if (wr == 0) PG8_BAR; }
    PG8_BAR;
    if constexpr (Epi::AFTER_DRAIN) { E.fused(acc, cur, wr, wc, fr, fq, lds, wid, lane); S.done(cur); }
#undef PG8_SA
#undef PG8_SB
#undef PG8_STAGE
#undef PG8_LDA
#undef PG8_LDB
#undef PG8_MMA
#undef PG8_WAIT_V
#undef PG8_WAIT_L
#undef PG8_BAR
#undef PG8_SCHED
}
}
#define XB_TMO      128
#define XB_XCNT(j)  (256  + 64 * (j))
#define XB_XSUB(j)  (1280 + 64 * (j))
#define XB_XGEN(j)  (2304 + 64 * (j))
#define XB_TOP      3328
#define XB_TOPGEN   3392
#define XCD_BAR_WORDS 3456
#define XB_SPIN_CAP (1u << 18)

__device__ __forceinline__ unsigned xb_ld(unsigned* p)              { return __hip_atomic_load(p, __ATOMIC_RELAXED, __HIP_MEMORY_SCOPE_AGENT); }
__device__ __forceinline__ unsigned xb_add(unsigned* p, unsigned v) { return __hip_atomic_fetch_add(p, v, __ATOMIC_RELAXED, __HIP_MEMORY_SCOPE_AGENT); }
__device__ __forceinline__ unsigned xb_xcc_id() { return (unsigned)__builtin_amdgcn_s_getreg((3 << 11) | 20) & 0xFu; }
#define XB_SPIN(cond, bar) do { unsigned _sp = 0; while (cond) { __builtin_amdgcn_s_sleep(1); \
    if ((++_sp & 255u) == 0u) { if (xb_ld(&(bar)[XB_TMO])) break; if (_sp > XB_SPIN_CAP) { atomicAdd(&(bar)[XB_TMO], 1u); break; } } } } while (0)

struct XcdBarrier {
    unsigned* bar; unsigned x;
    unsigned expect;
    volatile LAS unsigned* st;
};

__device__ __forceinline__ XcdBarrier xcd_barrier_post(unsigned* bar, volatile LAS unsigned* st, unsigned expect = 0u) {
    XcdBarrier b; b.bar = bar; b.x = xb_xcc_id(); b.st = st; b.expect = expect;
    if (threadIdx.x == 0) (void)xb_add(&bar[XB_XCNT(b.x)], 1u);
    return b;
}
__device__ __forceinline__ void xcd_barrier_complete(unsigned* bar, unsigned x, unsigned& nloc, unsigned& nx, unsigned expect) {
    const unsigned G = expect ? expect : gridDim.x * gridDim.y * gridDim.z;
    unsigned sum, cnt, mine, sp = 0u;
    for (;;) {
        sum = 0u; cnt = 0u; mine = 0u;
#pragma unroll
        for (unsigned j = 0; j < 16; ++j) { const unsigned c = xb_ld(&bar[XB_XCNT(j)]); sum += c; cnt += (c > 0u) ? 1u : 0u; mine = (j == x) ? c : mine; }
        if (sum == G) break;
        __builtin_amdgcn_s_sleep(1);
        if ((++sp & 255u) == 0u) { if (xb_ld(&bar[XB_TMO])) break; if (sp > XB_SPIN_CAP) { atomicAdd(&bar[XB_TMO], 1u); break; } }
    }
    nloc = mine > 0u ? mine : 1u; nx = cnt > 0u ? cnt : 1u;
}

__device__ __forceinline__ void xcd_barrier(const XcdBarrier& b) {
    asm volatile("s_waitcnt vmcnt(0)" ::: "memory");
    __syncthreads();
    if (threadIdx.x == 0) {
        unsigned* bar = b.bar;
        __builtin_amdgcn_s_waitcnt(0);
        unsigned nloc = b.st[0], nx = b.st[1];
        if (nloc == 0u) { xcd_barrier_complete(bar, b.x, nloc, nx, b.expect); b.st[0] = nloc; b.st[1] = nx; }
        const unsigned old = xb_add(&bar[XB_XSUB(b.x)], 1u);
        const unsigned gen = old / nloc;
        if (old + 1u == (gen + 1u) * nloc) {
            __builtin_amdgcn_fence(__ATOMIC_RELEASE, "agent");
            asm volatile("s_waitcnt vmcnt(0)" ::: "memory");
            const unsigned og = xb_add(&bar[XB_TOP], 1u);
            const unsigned tg = og / nx;
            if (og + 1u == (tg + 1u) * nx) xb_add(&bar[XB_TOPGEN], 1u);
            else XB_SPIN(xb_ld(&bar[XB_TOPGEN]) == tg, bar);
            __builtin_amdgcn_fence(__ATOMIC_ACQUIRE, "agent");
            xb_add(&bar[XB_XGEN(b.x)], 1u);
            asm volatile("s_waitcnt vmcnt(0)" ::: "memory");
        } else {
            XB_SPIN(xb_ld(&bar[XB_XGEN(b.x)]) == gen, bar);
            __builtin_amdgcn_fence(__ATOMIC_ACQUIRE, "agent");
            asm volatile("s_waitcnt vmcnt(0)" ::: "memory");
        }
    }
    __syncthreads();
}

typedef unsigned short bf16;
typedef float f32x4 __attribute__((ext_vector_type(4)));
typedef unsigned u32x4 __attribute__((ext_vector_type(4)));
typedef unsigned u32x2 __attribute__((ext_vector_type(2)));
typedef GAS unsigned gu32;
#define RLX_AGENT __ATOMIC_RELAXED, __HIP_MEMORY_SCOPE_AGENT
constexpr int DM = 4096, SEQ = 4096, NB = 2, M = NB * SEQ, BW = 2048, NH = 16, HD = 128, INC = 36864, DEPTH = 2;
constexpr int NT18 = 18;
constexpr float RMS_EPS = 1e-6f, ATT_SCALE = 0.08838834764831845f;
constexpr size_t MiB = 1u << 20;
constexpr size_t WS_CTL = 0, CTL_ZERO_BYTES = 65536, WS_ROPE = 1 * MiB, WS_KMEAN = 2 * MiB, WS_KM = 3 * MiB, WS_WIN = 4 * MiB, WIN_BYTES = 288 * MiB, WS_WBR = WS_WIN + 2 * WIN_BYTES, WBR_BYTES = 48 * MiB,
                 WS_WO = WS_WBR + 2 * WBR_BYTES, WO_BYTES = 32 * MiB, WS_H = WS_WO + 2 * WO_BYTES, WS_T = WS_H + 64 * MiB, T_BYTES = 32 * MiB, WS_OBR = WS_T + NT18 * T_BYTES,
                 WS_X1 = WS_OBR + 96 * MiB, WS_Y = WS_X1 + 64 * MiB, WS_OUT = WS_Y + 64 * MiB, WS_H8 = WS_OUT + 64 * MiB, WS_Y8 = WS_H8 + 32 * MiB, WS_END = WS_Y8 + 32 * MiB;
constexpr int NGATE = INC - 4 * BW, NPROJ = 4 * BW;
constexpr size_t W8_OFF = 128 * MiB;
constexpr size_t TE = (size_t)M * BW;
constexpr int CW_TMO = 0, CW_QCLAIM = 64, CW_XID = 1024, CW_GRP = 1536, CW_BAR = 4096, CW_BARH = 8192  ;
constexpr int NWAVES = 8;
constexpr int RING_BYTES = 131072, LDS_BYTES = 147456, MISC_OFF = LDS_BYTES - 256;
constexpr int PH_PER_LAYER = 7, N_PHASES = 1 + DEPTH * PH_PER_LAYER;
#ifndef MK_PER_PHASE
#define MK_PER_PHASE 0
#endif

__device__ __forceinline__ float bf2f(unsigned short b) { return __uint_as_float(((unsigned)b) << 16); }
__device__ __forceinline__ unsigned f2bf(float f) { unsigned u = __float_as_uint(f); return (u + 0x7fffu + ((u >> 16) & 1u)) >> 16; }
__device__ __forceinline__ unsigned pk2(float lo, float hi) { return f2bf(lo) | (f2bf(hi) << 16); }
template <int X> __device__ __forceinline__ float swz_xor(float v) { return __uint_as_float((unsigned)__builtin_amdgcn_ds_swizzle((int)__float_as_uint(v), (X << 10) | 0x1f)); }
__device__ __forceinline__ float wave_sum(float v) {
    v += swz_xor<1>(v); v += swz_xor<2>(v); v += swz_xor<4>(v); v += swz_xor<8>(v); v += swz_xor<16>(v);
    auto rr = __builtin_amdgcn_permlane32_swap(__float_as_uint(v), __float_as_uint(v), false, false); return __uint_as_float(rr[0]) + __uint_as_float(rr[1]);
}
__device__ __forceinline__ float sigmoidf_(float z) { return __builtin_amdgcn_rcpf(1.0f + __builtin_amdgcn_exp2f(z * -1.4426950408889634f)); }
__device__ __forceinline__ float siluf_(float z) { return z * __builtin_amdgcn_rcpf(1.0f + __builtin_amdgcn_exp2f(z * -1.4426950408889634f)); }
__device__ __forceinline__ void unpack8(const u32x4 w, float (&f)[8]) {
    f[0] = __uint_as_float(w.x << 16); f[1] = __uint_as_float(w.x & 0xffff0000u); f[2] = __uint_as_float(w.y << 16); f[3] = __uint_as_float(w.y & 0xffff0000u);
    f[4] = __uint_as_float(w.z << 16); f[5] = __uint_as_float(w.z & 0xffff0000u); f[6] = __uint_as_float(w.w << 16); f[7] = __uint_as_float(w.w & 0xffff0000u); }
__device__ __forceinline__ void ld8(const bf16* p, float (&f)[8]) { unpack8(*(const u32x4*)p, f); }

namespace pg8 {
template <bool I8> struct EpiProjT {
    static constexpr bool PERM = true, AFTER_DRAIN = false; static __device__ __forceinline__ bool keep(const Unit&) { return false; }
    bf16_t* T; const float* rope; const float* bias; const float* sa; const float* sb; int all8;
    static __device__ __forceinline__ f32x4 dq(const f32x4& a, float sr, const f32x4& sc) { if (!I8) return a; const i32x4 c = __builtin_bit_cast(i32x4, a); f32x4 r;
#pragma unroll
        for (int e = 0; e < 4; ++e) r[e] = (float)c[e] * (sr * sc[e]);
        return r; }
    __device__ __forceinline__ void operator()(const f32x4 (&acc)[2][2][4][2], const Unit& u, int wr, int wc, int fr, int fq) const {
        { const int l_ = mk_lane(); fr = l_ & 15; fq = l_ >> 4; }
        const int up = I8 ? (all8 ? INC / BM - 1 : NGATE / BM - 1) - u.pn : u.pn;
        const int pn = !I8 ? up + 32 : all8 ? (u.pn < 48 ? u.pn + 96 : (u.pn < 112 ? u.pn - 16 : u.pn - 112)) : (up < 32 ? up : up + 32);
        const int row0 = u.pm * BM + wr * 64 + fr, t = pn >> 3, colt = (pn & 7) * BM;
        bf16_t* base = T + (size_t)t * TE; const int col0 = colt + wc * 32 + 8 * fq;
        const int mode = (t < 2) ? (wc == 0 ? 1 : 0) : ((t >= 4 && t < 8) ? 4 : ((t == 3 || t == 11) ? 2 : (t >= 12 ? 3 : 0)));
        f32x4 sbv[2][2]; float sav[2][4];
#pragma unroll
        for (int bj = 0; bj < 2; ++bj)
#pragma unroll
            for (int n = 0; n < 2; ++n) sbv[bj][n] = I8 ? *(const f32x4*)(sb + u.pn * BM + wc * 32 + 8 * fq + bj * HALF + 4 * n) : (f32x4){1.f, 1.f, 1.f, 1.f};
#pragma unroll
        for (int ai = 0; ai < 2; ++ai)
#pragma unroll
            for (int m = 0; m < 4; ++m) sav[ai][m] = I8 ? sa[row0 + ai * HALF + m * 16] : 1.f;
        if (I8) { asm volatile("s_waitcnt vmcnt(0)" ::: "memory");
#pragma unroll
            for (int bj = 0; bj < 2; ++bj)
#pragma unroll
                for (int n = 0; n < 2; ++n) asm volatile("" : "+v"(sbv[bj][n])); }
#define ACCV(ai_, bj_, m_, n_) dq(acc[ai_][bj_][m_][n_], sav[ai_][m_], sbv[bj_][n_])
#define EPI_STORE8(rowp_, v0_, v1_) do { u32x4 w_; w_.x = cvt_pk_bf16((v0_)[0], (v0_)[1]); w_.y = cvt_pk_bf16((v0_)[2], (v0_)[3]); w_.z = cvt_pk_bf16((v1_)[0], (v1_)[1]); w_.w = cvt_pk_bf16((v1_)[2], (v1_)[3]); *(u32x4*)(rowp_) = w_; } while (0)
        if (mode == 1) {
            const float sg = (fq < 2) ? -1.f : 1.f; f32x4 csn[4];
            { const f32x4* tp = (const f32x4*)(rope + ((size_t)(row0 & (SEQ - 1)) * 16 + 8 * (fq & 1)) * 2); csn[0] = tp[0]; csn[1] = tp[1]; csn[2] = tp[2]; csn[3] = tp[3]; }
#pragma unroll
            for (int ai = 0; ai < 2; ++ai)
#pragma unroll
                for (int m = 0; m < 4; ++m) { const int row = row0 + ai * HALF + m * 16; bf16_t* rowp = base + (size_t)row * BW + col0;
                    f32x4 cs[2][2]; cs[0][0] = csn[0]; cs[0][1] = csn[1]; cs[1][0] = csn[2]; cs[1][1] = csn[3];
                    if (ai * 4 + m < 7) { const int rown = row0 + ((ai * 4 + m + 1) >> 2) * HALF + ((ai * 4 + m + 1) & 3) * 16;
                        const f32x4* tp = (const f32x4*)(rope + ((size_t)(rown & (SEQ - 1)) * 16 + 8 * (fq & 1)) * 2); csn[0] = tp[0]; csn[1] = tp[1]; csn[2] = tp[2]; csn[3] = tp[3]; }
#pragma unroll
                    for (int bj = 0; bj < 2; ++bj) { f32x4 v[2];
#pragma unroll
                        for (int n = 0; n < 2; ++n) { f32x4 a = ACCV(ai, bj, m, n); f32x4 p;
#pragma unroll
                            for (int e = 0; e < 4; ++e) { auto rr = __builtin_amdgcn_permlane32_swap(__float_as_uint(a[e]), __float_as_uint(a[e]), false, false); p[e] = __uint_as_float(fq >= 2 ? rr[0] : rr[1]); }
                            a[0] = a[0] * cs[n][0][0] + sg * p[0] * cs[n][0][1]; a[1] = a[1] * cs[n][0][2] + sg * p[1] * cs[n][0][3];
                            a[2] = a[2] * cs[n][1][0] + sg * p[2] * cs[n][1][1]; a[3] = a[3] * cs[n][1][2] + sg * p[3] * cs[n][1][3]; v[n] = a; }
                        EPI_STORE8(rowp + bj * HALF, v[0], v[1]); } }
        } else if (mode == 4) {
            bf16_t* dst = T + (size_t)((wc < 2) ? 5 : 4) * TE + (pn - 32) * 64 + 32 * (wc & 1) + 8 * fq;
#pragma unroll
            for (int ai = 0; ai < 2; ++ai)
#pragma unroll
                for (int m = 0; m < 4; ++m) { f32x4 v[2];
#pragma unroll
                    for (int n = 0; n < 2; ++n) { const f32x4 a = ACCV(ai, 0, m, n); f32x4 b = ACCV(ai, 1, m, n);
                        if (wc >= 2) { b[0] = siluf_(b[0]); b[1] = siluf_(b[1]); b[2] = siluf_(b[2]); b[3] = siluf_(b[3]); }
                        v[n] = a * b; }
                    EPI_STORE8(dst + (size_t)(row0 + ai * HALF + m * 16) * BW, v[0], v[1]); }
        } else if (mode == 2) {
#pragma unroll
            for (int ai = 0; ai < 2; ++ai)
#pragma unroll
                for (int m = 0; m < 4; ++m) { bf16_t* rowp = base + (size_t)(row0 + ai * HALF + m * 16) * BW + col0;
#pragma unroll
                    for (int bj = 0; bj < 2; ++bj) { f32x4 v[2];
#pragma unroll
                        for (int n = 0; n < 2; ++n) { f32x4 a = ACCV(ai, bj, m, n); a[0] = siluf_(a[0]); a[1] = siluf_(a[1]); a[2] = siluf_(a[2]); a[3] = siluf_(a[3]); v[n] = a; }
                        EPI_STORE8(rowp + bj * HALF, v[0], v[1]); } }
        } else if (mode == 3) {
            f32x4 bv[2][2];
#pragma unroll
            for (int bj = 0; bj < 2; ++bj)
#pragma unroll
                for (int n = 0; n < 2; ++n) bv[bj][n] = *(const f32x4*)(bias + (t - 12) * BW + col0 + bj * HALF + 4 * n);
#pragma unroll
            for (int ai = 0; ai < 2; ++ai)
#pragma unroll
                for (int m = 0; m < 4; ++m) { bf16_t* rowp = base + (size_t)(row0 + ai * HALF + m * 16) * BW + col0;
#pragma unroll
                    for (int bj = 0; bj < 2; ++bj) { f32x4 v[2];
#pragma unroll
                        for (int n = 0; n < 2; ++n) { f32x4 a = ACCV(ai, bj, m, n) + bv[bj][n]; a[0] = sigmoidf_(a[0]); a[1] = sigmoidf_(a[1]); a[2] = sigmoidf_(a[2]); a[3] = sigmoidf_(a[3]); v[n] = a; }
                        EPI_STORE8(rowp + bj * HALF, v[0], v[1]); } }
        } else {
#pragma unroll
            for (int ai = 0; ai < 2; ++ai)
#pragma unroll
                for (int m = 0; m < 4; ++m) { bf16_t* rowp = base + (size_t)(row0 + ai * HALF + m * 16) * BW + col0;
#pragma unroll
                    for (int bj = 0; bj < 2; ++bj) { const f32x4 v0 = ACCV(ai, bj, m, 0), v1 = ACCV(ai, bj, m, 1); EPI_STORE8(rowp + bj * HALF, v0, v1); } }
        }
#undef EPI_STORE8
#undef ACCV
    }
};
struct EpiBranch {
    static constexpr bool PERM = true, AFTER_DRAIN = false; static __device__ __forceinline__ bool keep(const Unit& u) { return (u.pm >> 5) < 2; }
    const bf16_t* G6; bf16_t* Y;
    __device__ __forceinline__ void operator()(f32x4 (&acc)[2][2][4][2], const Unit& u, int wr, int wc, int fr, int fq) const {
        const int br = u.pm >> 5, pm = u.pm & 31, pn = u.pn & 15;
        const int row0 = pm * BM + wr * 64 + fr, col0 = pn * BM + wc * 32 + 8 * fq;
        const bf16_t* gb = G6 + (size_t)(2 * br + (pn >> 3)) * TE + (col0 & (BW - 1));
        if (br < 2) {
#pragma unroll
            for (int ai = 0; ai < 2; ++ai) { u32x4 gv[4][2], gnv[4][2];
#pragma unroll
                for (int m = 0; m < 4; ++m) { const size_t ro = (size_t)(row0 + ai * HALF + m * 16) * BW;
#pragma unroll
                    for (int bj = 0; bj < 2; ++bj) { gv[m][bj] = *(const u32x4*)(gb + ro + bj * HALF); gnv[m][bj] = *(const u32x4*)(gb + 2 * TE + ro + bj * HALF); } }
                asm volatile("s_waitcnt vmcnt(0)" ::: "memory");
#pragma unroll
                for (int m = 0; m < 4; ++m)
#pragma unroll
                    for (int bj = 0; bj < 2; ++bj) { float g[8], gn[8]; unpack8(gv[m][bj], g); unpack8(gnv[m][bj], gn);
#pragma unroll
                        for (int e = 0; e < 8; ++e) g[e] = fmaxf(g[e], 1e-30f) * __builtin_amdgcn_rcpf(fmaxf(gn[e], 1e-30f));
                        f32x4& v0 = acc[ai][bj][m][0]; f32x4& v1 = acc[ai][bj][m][1];
                        v0[0] *= g[0]; v0[1] *= g[1]; v0[2] *= g[2]; v0[3] *= g[3]; v1[0] *= g[4]; v1[1] *= g[5]; v1[2] *= g[6]; v1[3] *= g[7]; } }
        } else {
            u32x4 gv[2][4][2];
#pragma unroll
            for (int ai = 0; ai < 2; ++ai)
#pragma unroll
                for (int m = 0; m < 4; ++m)
#pragma unroll
                    for (int bj = 0; bj < 2; ++bj) gv[ai][m][bj] = *(const u32x4*)(gb + (size_t)(row0 + ai * HALF + m * 16) * BW + bj * HALF);
            asm volatile("s_waitcnt vmcnt(0)" ::: "memory");
#pragma unroll
            for (int ai = 0; ai < 2; ++ai)
#pragma unroll
                for (int m = 0; m < 4; ++m) { const int row = row0 + ai * HALF + m * 16;
#pragma unroll
                    for (int bj = 0; bj < 2; ++bj) { float g[8]; unpack8(gv[ai][m][bj], g);
#pragma unroll
                        for (int e = 0; e < 8; ++e) g[e] = fmaxf(g[e], 1e-30f);
                        const f32x4 v0 = acc[ai][bj][m][0], v1 = acc[ai][bj][m][1]; u32x4 w;
                        w.x = cvt_pk_bf16(v0[0] * g[0], v0[1] * g[1]); w.y = cvt_pk_bf16(v0[2] * g[2], v0[3] * g[3]); w.z = cvt_pk_bf16(v1[0] * g[4], v1[1] * g[5]); w.w = cvt_pk_bf16(v1[2] * g[6], v1[3] * g[7]);
                        *(u32x4*)(Y + (size_t)row * DM + col0 + bj * HALF) = w; } }
        }
    }
};
struct EpiBf16Plain {
    static constexpr bool PERM = true, AFTER_DRAIN = false; static __device__ __forceinline__ bool keep(const Unit&) { return false; }
    bf16_t* O; int ldc, pad;
    __device__ __forceinline__ void operator()(const f32x4 (&acc)[2][2][4][2], const Unit& u, int wr, int wc, int fr, int fq) const {
        const int row0 = u.pm * BM + wr * 64 + fr, col0 = u.pn * BM + wc * 32 + 8 * fq;
#pragma unroll
        for (int ai = 0; ai < 2; ++ai)
#pragma unroll
            for (int m = 0; m < 4; ++m) { bf16_t* rowp = O + (size_t)(row0 + ai * HALF + m * 16) * ldc + col0;
#pragma unroll
                for (int bj = 0; bj < 2; ++bj) { const f32x4 v0 = acc[ai][bj][m][0], v1 = acc[ai][bj][m][1]; u32x4 w;
                    w.x = cvt_pk_bf16(v0[0], v0[1]); w.y = cvt_pk_bf16(v0[2], v0[3]); w.z = cvt_pk_bf16(v1[0], v1[1]); w.w = cvt_pk_bf16(v1[2], v1[3]); *(u32x4*)(rowp + bj * HALF) = w; } }
    }
};
struct EpiOut8 {
    static constexpr bool PERM = true, AFTER_DRAIN = false; static __device__ __forceinline__ bool keep(const Unit&) { return false; }
    bf16_t* O; const float* sa; const float* sb;
    __device__ __forceinline__ void operator()(const f32x4 (&acc)[2][2][4][2], const Unit& u, int wr, int wc, int fr, int fq) const {
        { const int l_ = mk_lane(); fr = l_ & 15; fq = l_ >> 4; }
        const int row0 = u.pm * BM + wr * 64 + fr, col0 = u.pn * BM + wc * 32 + 8 * fq;
        f32x4 sbv[2][2]; float sav[2][4];
#pragma unroll
        for (int bj = 0; bj < 2; ++bj)
#pragma unroll
            for (int n = 0; n < 2; ++n) sbv[bj][n] = *(const f32x4*)(sb + col0 + bj * HALF + 4 * n);
#pragma unroll
        for (int ai = 0; ai < 2; ++ai)
#pragma unroll
            for (int m = 0; m < 4; ++m) sav[ai][m] = sa[row0 + ai * HALF + m * 16];
        asm volatile("s_waitcnt vmcnt(0)" ::: "memory");
#pragma unroll
        for (int bj = 0; bj < 2; ++bj)
#pragma unroll
            for (int n = 0; n < 2; ++n) asm volatile("" : "+v"(sbv[bj][n]));
#pragma unroll
        for (int ai = 0; ai < 2; ++ai)
#pragma unroll
            for (int m = 0; m < 4; ++m) { bf16_t* rowp = O + (size_t)(row0 + ai * HALF + m * 16) * DM + col0;
#pragma unroll
                for (int bj = 0; bj < 2; ++bj) { const f32x4 v0 = EpiProjT<true>::dq(acc[ai][bj][m][0], sav[ai][m], sbv[bj][0]), v1 = EpiProjT<true>::dq(acc[ai][bj][m][1], sav[ai][m], sbv[bj][1]); u32x4 w;
                    w.x = cvt_pk_bf16(v0[0], v0[1]); w.y = cvt_pk_bf16(v0[2], v0[3]); w.z = cvt_pk_bf16(v1[0], v1[1]); w.w = cvt_pk_bf16(v1[2], v1[3]); *(u32x4*)(rowp + bj * HALF) = w; } }
    }
};
struct BranchOrder {
    StaticOrder base;
    __device__ void init(int G_, int c_) { base.init(M, DM, G_, c_); }
    __device__ bool next(int i, Unit& u) const { const int tile = i / 3, br = i - 3 * tile; Unit v; if (!base.next(tile, v)) return false; u.pm = v.pm + 32 * br; u.pn = v.pn + 16 * br; return true; }
    __device__ __forceinline__ void a_ready(const Unit&) const {}
    __device__ __forceinline__ void done(const Unit&) const {}
};
struct ProjOrder {
    StaticOrder base; const bf16_t* Tk; bf16_t* KM; PG8_LAS float* red; int all8, wave;
    __device__ void init(int M_, int N_, int G_, int c_, const bf16_t* Tk_, bf16_t* KM_, PG8_LAS float* red_, int all8_, int wave_) { base.init(M_, N_, G_, c_); Tk = Tk_; KM = KM_; red = red_; all8 = all8_; wave = wave_; }
    __device__ bool next(int i, Unit& u) const { return base.next(i, u); }
    __device__ __forceinline__ void a_ready(const Unit&) const {}
    __device__ __forceinline__ void done(const Unit& u) const {
        const int up = NGATE / BM - 1 - u.pn, o = all8 ? (u.pn < 48 ? u.pn + 96 : (u.pn < 112 ? u.pn - 16 : u.pn - 112)) : (up < 32 ? up : up + 32);
        if (o < 8 || o >= 16) return;
        asm volatile("s_waitcnt vmcnt(0)" ::: "memory"); __syncthreads();
        const int lane = mk_lane(), c8 = o - 8, b = u.pm >> 4, j = u.pm & 15;
        const bf16_t* kp = Tk + (size_t)(u.pm * BM + wave * 32) * 2048 + c8 * 256 + 4 * lane; float a4[4] = {0.f, 0.f, 0.f, 0.f};
#pragma unroll
        for (int h = 0; h < 2; ++h) { u32x2 v[16];
#pragma unroll
            for (int r = 0; r < 16; ++r) v[r] = *(const u32x2*)(kp + (size_t)(16 * h + r) * 2048);
#pragma unroll
            for (int r = 0; r < 16; ++r) { a4[0] += __uint_as_float(v[r].x << 16); a4[1] += __uint_as_float(v[r].x & 0xffff0000u); a4[2] += __uint_as_float(v[r].y << 16); a4[3] += __uint_as_float(v[r].y & 0xffff0000u); } }
#pragma unroll
        for (int e = 0; e < 4; ++e) red[wave * 256 + 4 * lane + e] = a4[e];
        __syncthreads();
        const int tid = wave * 64 + lane;
        if (tid < 256) { float t = 0.f;
#pragma unroll
            for (int w8 = 0; w8 < 8; ++w8) t += red[w8 * 256 + tid];
            const float km = t * (1.0f / 256.0f); const unsigned kh = (__float_as_uint(km) + 0x7fffu + ((__float_as_uint(km) >> 16) & 1u)) >> 16; const float kl = km - __uint_as_float(kh << 16);
            const unsigned klb = (__float_as_uint(kl) + 0x7fffu + ((__float_as_uint(kl) >> 16) & 1u)) >> 16;
            const int bh = b * 16 + 2 * c8 + (tid >> 7), d = tid & 127;
            KM[((size_t)bh * 32 + j) * 128 + d] = (bf16_t)kh; KM[((size_t)bh * 32 + 16 + j) * 128 + d] = (bf16_t)klb; }
    }
};
}

__device__ __forceinline__ float wave_max(float v) {
    v = fmaxf(v, swz_xor<1>(v)); v = fmaxf(v, swz_xor<2>(v)); v = fmaxf(v, swz_xor<4>(v)); v = fmaxf(v, swz_xor<8>(v)); v = fmaxf(v, swz_xor<16>(v));
    auto rr = __builtin_amdgcn_permlane32_swap(__float_as_uint(v), __float_as_uint(v), false, false); return fmaxf(__uint_as_float(rr[0]), __uint_as_float(rr[1]));
}
__device__ __forceinline__ unsigned q8(float v, float sc) { const float q = fminf(fmaxf(__builtin_rintf(v * sc), -127.f), 127.f); return (unsigned)(int)q & 0xffu; }
__device__ __forceinline__ unsigned q8x4(float a, float b, float c, float d, float sc) { return q8(a, sc) | (q8(b, sc) << 8) | (q8(c, sc) << 16) | (q8(d, sc) << 24); }
__device__ __forceinline__ int remap_conv_col(int n) { if (n < 4 * BW || n >= 8 * BW) return n; const int t = n >> 11, ch = n & (BW - 1), slot = (t == 5) ? 0 : (t == 4) ? 1 : (t == 6) ? 2 : 3; return 4 * BW + (ch >> 6) * 256 + slot * 64 + (ch & 63); }
__device__ __forceinline__ void quant_block(const float* W, int N, int ns, unsigned char* W8, float* sb, LAS unsigned char* Lb, int wave, int lane) {
    LAS float* scr = (LAS float*)(Lb + wave * 16384); LAS float* cmw = (LAS float*)(Lb + 12288);
    f32x4 m = {0.f, 0.f, 0.f, 0.f};
    for (int sub = 0; sub < 8; ++sub) { const int k0 = 512 * wave + 64 * sub; f32x4 w[8];
#pragma unroll
        for (int i = 0; i < 8; ++i) w[i] = *(const f32x4*)(W + (size_t)(k0 + 8 * i + (lane >> 3)) * N + ns + (lane & 7) * 4);
#pragma unroll
        for (int i = 0; i < 8; ++i) m = __builtin_elementwise_max(m, __builtin_elementwise_abs(w[i])); }
#pragma unroll
    for (int e = 0; e < 4; ++e) { float t = m[e]; t = fmaxf(t, swz_xor<8>(t)); t = fmaxf(t, swz_xor<16>(t));
        auto rr = __builtin_amdgcn_permlane32_swap(__float_as_uint(t), __float_as_uint(t), false, false); t = fmaxf(__uint_as_float(rr[0]), __uint_as_float(rr[1]));
        if (lane < 8) cmw[wave * 32 + lane * 4 + e] = t; }
    __syncthreads();
    float sc[4];
#pragma unroll
    for (int j = 0; j < 4; ++j) { const int n = (lane >> 3) + 8 * j; float am = cmw[n];
#pragma unroll
        for (int w8 = 1; w8 < 8; ++w8) am = fmaxf(am, cmw[w8 * 32 + n]);
        sc[j] = am > 0.f ? 127.0f / am : 0.f; if (wave == 0 && (lane & 7) == 0) sb[n] = am * (1.0f / 127.0f); }
    const int c = lane & 7;
    for (int sub = 0; sub < 8; ++sub) { const int k0 = 512 * wave + 64 * sub; f32x4 w[8];
#pragma unroll
        for (int i = 0; i < 8; ++i) w[i] = *(const f32x4*)(W + (size_t)(k0 + 8 * i + (lane >> 3)) * N + ns + (lane & 7) * 4);
#pragma unroll
        for (int i = 0; i < 8; ++i) { LAS float* d = scr + (8 * i + (lane >> 3)) * 33 + (lane & 7) * 4; d[0] = w[i][0]; d[1] = w[i][1]; d[2] = w[i][2]; d[3] = w[i][3]; }
        asm volatile("s_waitcnt lgkmcnt(0)" ::: "memory");
#pragma unroll
        for (int j = 0; j < 4; ++j) { const int n = (lane >> 3) + 8 * j; const LAS float* sp = scr + (8 * c) * 33 + n;
            u32x2 o; o.x = q8x4(sp[0 * 33], sp[1 * 33], sp[2 * 33], sp[3 * 33], sc[j]); o.y = q8x4(sp[4 * 33], sp[5 * 33], sp[6 * 33], sp[7 * 33], sc[j]);
            *(u32x2*)(W8 + (size_t)n * DM + k0 + 8 * c) = o; }
        asm volatile("s_waitcnt lgkmcnt(0)" ::: "memory"); }
    __syncthreads();
}
template <bool REMAP = false>
__device__ __forceinline__ void transpose_item(const float* W, int K, int N, bf16* WT, LAS float* scr, int item, int lane) {
    const int nblk = N / 32, kb = item / nblk, nb = item % nblk, k0 = 64 * kb, n0 = 32 * nb, n0d = REMAP ? remap_conv_col(n0) : n0;
    f32x4 w[8];
#pragma unroll
    for (int i = 0; i < 8; ++i) w[i] = __builtin_nontemporal_load((const f32x4*)(W + (size_t)(k0 + 8 * i + (lane >> 3)) * N + n0 + (lane & 7) * 4));
#pragma unroll
    for (int i = 0; i < 8; ++i) { LAS float* d = scr + (8 * i + (lane >> 3)) * 33 + (lane & 7) * 4; d[0] = w[i][0]; d[1] = w[i][1]; d[2] = w[i][2]; d[3] = w[i][3]; }
    asm volatile("s_waitcnt lgkmcnt(0)" ::: "memory");
    const int c = lane & 7;
#pragma unroll
    for (int j = 0; j < 4; ++j) { const int n = (lane >> 3) + 8 * j; const LAS float* s = scr + (8 * c) * 33 + n;
        u32x4 o; o.x = pk2(s[0 * 33], s[1 * 33]); o.y = pk2(s[2 * 33], s[3 * 33]); o.z = pk2(s[4 * 33], s[5 * 33]); o.w = pk2(s[6 * 33], s[7 * 33]);
        *(u32x4*)(WT + (size_t)(n0d + n) * K + k0 + 8 * c) = o; }
    asm volatile("s_waitcnt lgkmcnt(0)" ::: "memory");
}
__device__ __forceinline__ void rope_entry(float2* tab, int idx) {
    const int pos = idx >> 4, i = idx & 15;
    const float inv = exp2f(-(float)i * (18.931568569324174f / 16.0f));
    const float ang = (float)pos * inv;
    const double a = (double)ang; const double kq = __builtin_rint(a * 0.63661977236758134308);
    const double r = (a - kq * 1.5707963267948966192) - kq * 6.123233995736766e-17; const double r2 = r * r;
    const double sr = r * (1.0 + r2 * (-1.0 / 6 + r2 * (1.0 / 120 + r2 * (-1.0 / 5040 + r2 * (1.0 / 362880 + r2 * (-1.0 / 39916800 + r2 * (1.0 / 6227020800.0)))))));
    const double cr = 1.0 + r2 * (-0.5 + r2 * (1.0 / 24 + r2 * (-1.0 / 720 + r2 * (1.0 / 40320 + r2 * (-1.0 / 3628800 + r2 * (1.0 / 479001600.0 + r2 * (-1.0 / 87178291200.0)))))));
    const int q = ((int)kq) & 3; double s, c;
    if (q == 0) { s = sr; c = cr; } else if (q == 1) { s = cr; c = -sr; } else if (q == 2) { s = -sr; c = -cr; } else { s = -cr; c = sr; }
    tab[idx] = make_float2((float)c, (float)s);
}
__device__ __forceinline__ void rmsnorm_row_bf16(const float* xrow, const float* g, bf16* orow, unsigned char* o8row, float* sa, int lane) {
    const f32x4* xr = (const f32x4*)xrow + lane; f32x4 v[16]; float s = 0.f;
#pragma unroll
    for (int j = 0; j < 16; ++j) { v[j] = xr[64 * j]; s += (v[j].x * v[j].x + v[j].y * v[j].y) + (v[j].z * v[j].z + v[j].w * v[j].w); }
    const float rs = 1.0f / sqrtf(wave_sum(s) * (1.0f / DM) + RMS_EPS);
    u32x2* o = (u32x2*)orow + lane; float am = 0.f;
#pragma unroll
    for (int j = 0; j < 16; ++j) { const f32x4 gv = ((const f32x4*)g)[lane + 64 * j]; v[j] = v[j] * rs * gv; u32x2 w; w.x = pk2(v[j].x, v[j].y); w.y = pk2(v[j].z, v[j].w); o[64 * j] = w;
        am = fmaxf(am, fmaxf(fmaxf(fabsf(v[j].x), fabsf(v[j].y)), fmaxf(fabsf(v[j].z), fabsf(v[j].w)))); }
    am = wave_max(am); const float sc = am > 0.f ? 127.0f / am : 0.f; unsigned* o8 = (unsigned*)o8row + lane;
#pragma unroll
    for (int j = 0; j < 16; ++j) o8[64 * j] = q8x4(v[j].x, v[j].y, v[j].z, v[j].w, sc);
    if (lane == 0) *sa = am * (1.0f / 127.0f);
}
__device__ __forceinline__ void yq_row(const bf16* yrow, unsigned char* y8row, float* sa, int lane) {
    float v[8][8]; float am = 0.f;
#pragma unroll
    for (int j = 0; j < 8; ++j) { ld8(yrow + 8 * lane + 512 * j, v[j]);
#pragma unroll
        for (int e = 0; e < 8; ++e) am = fmaxf(am, fabsf(v[j][e])); }
    am = wave_max(am); const float sc = am > 0.f ? 127.0f / am : 0.f;
#pragma unroll
    for (int j = 0; j < 8; ++j) { u32x2 q; q.x = q8x4(v[j][0], v[j][1], v[j][2], v[j][3], sc); q.y = q8x4(v[j][4], v[j][5], v[j][6], v[j][7], sc); *(u32x2*)(y8row + 8 * lane + 512 * j) = q; }
    if (lane == 0) *sa = am * (1.0f / 127.0f);
}
template <bool XIN_BF16, bool XOUT_BF16>
__device__ __forceinline__ void final_row(const void* xrow_, const bf16* orow, const float* gpost, void* xnrow_, const float* gnext, bf16* hrow, unsigned char* h8row, float* sa, int lane) {
    float v[8][8]; float s = 0.f;
#pragma unroll
    for (int j = 0; j < 8; ++j) { ld8(orow + 8 * lane + 512 * j, v[j]);
#pragma unroll
        for (int e = 0; e < 8; ++e) s += v[j][e] * v[j][e]; }
    const float rs = 1.0f / sqrtf(wave_sum(s) * (1.0f / DM) + RMS_EPS); float s2 = 0.f;
#pragma unroll
    for (int j = 0; j < 8; ++j) { const int e0 = 8 * lane + 512 * j; const f32x4 g0 = *(const f32x4*)(gpost + e0), g1 = *(const f32x4*)(gpost + e0 + 4); float xv[8];
        if (XIN_BF16) ld8((const bf16*)xrow_ + e0, xv); else { const f32x4 x0 = *(const f32x4*)((const float*)xrow_ + e0), x1 = *(const f32x4*)((const float*)xrow_ + e0 + 4);
#pragma unroll
            for (int e = 0; e < 4; ++e) { xv[e] = x0[e]; xv[4 + e] = x1[e]; } }
#pragma unroll
        for (int e = 0; e < 8; ++e) { const float r = xv[e] + v[j][e] * rs * (e < 4 ? g0[e & 3] : g1[e & 3]); v[j][e] = r; s2 += r * r; }
        if (XOUT_BF16) { u32x4 w; w.x = pk2(v[j][0], v[j][1]); w.y = pk2(v[j][2], v[j][3]); w.z = pk2(v[j][4], v[j][5]); w.w = pk2(v[j][6], v[j][7]); *(u32x4*)((bf16*)xnrow_ + e0) = w; }
        else { *(f32x4*)((float*)xnrow_ + e0) = (f32x4){v[j][0], v[j][1], v[j][2], v[j][3]}; *(f32x4*)((float*)xnrow_ + e0 + 4) = (f32x4){v[j][4], v[j][5], v[j][6], v[j][7]}; } }
    if (gnext) { const float rs2 = 1.0f / sqrtf(wave_sum(s2) * (1.0f / DM) + RMS_EPS); float am = 0.f;
#pragma unroll
        for (int j = 0; j < 8; ++j) { const int e0 = 8 * lane + 512 * j; const f32x4 g0 = *(const f32x4*)(gnext + e0), g1 = *(const f32x4*)(gnext + e0 + 4); u32x4 w;
#pragma unroll
            for (int e = 0; e < 8; ++e) { v[j][e] = v[j][e] * rs2 * (e < 4 ? g0[e & 3] : g1[e & 3]); am = fmaxf(am, fabsf(v[j][e])); }
            w.x = pk2(v[j][0], v[j][1]); w.y = pk2(v[j][2], v[j][3]); w.z = pk2(v[j][4], v[j][5]); w.w = pk2(v[j][6], v[j][7]);
            if (hrow) *(u32x4*)(hrow + e0) = w; }
        am = wave_max(am); const float sc = am > 0.f ? 127.0f / am : 0.f;
#pragma unroll
        for (int j = 0; j < 8; ++j) { u32x2 q; q.x = q8x4(v[j][0], v[j][1], v[j][2], v[j][3], sc); q.y = q8x4(v[j][4], v[j][5], v[j][6], v[j][7], sc); *(u32x2*)(h8row + 8 * lane + 512 * j) = q; }
        if (lane == 0) *sa = am * (1.0f / 127.0f); }
}

namespace att {
typedef short bf16x8 __attribute__((ext_vector_type(8)));
typedef short s16x4 __attribute__((ext_vector_type(4)));
typedef float f32x16 __attribute__((ext_vector_type(16)));
constexpr int KVBLK = 64;
constexpr int SHM_V = KVBLK * HD * 2, SHM_K = KVBLK * HD * 2;
constexpr int OFF_V = 0, OFF_K = 2 * SHM_V, OFF_G = OFF_K + 2 * SHM_K, OFF_WS = OFF_G + 8192, OFF_Q = OFF_WS + NWAVES * 64 * 4, ATT_LDS = OFF_Q + NWAVES * 8192;
constexpr float C2 = ATT_SCALE * 1.4426950408889634f;
constexpr float THR = 8.f;
#ifndef ATT_SD_MOBA
#define ATT_SD_MOBA 1
#endif
#ifndef ATT_QLDS
#define ATT_QLDS 0
#endif
#ifndef ATT_SD_SB
#define ATT_SD_SB 1
#endif
#define KSWZ(row, colB) ((row) * 256 + ((colB) ^ (((row) & 7) << 4)))
#define SBAR() __builtin_amdgcn_sched_barrier(0)
__device__ __forceinline__ int crow(int r, int hi) { return (r & 3) + 8 * (r >> 2) + 4 * hi; }
__device__ __forceinline__ unsigned cvtpk(float lo, float hi) { return pg8::cvt_pk_bf16(lo, hi); }
__device__ __forceinline__ float swap_sum(float v) { auto rr = __builtin_amdgcn_permlane32_swap(__float_as_uint(v), __float_as_uint(v), false, false); return __uint_as_float(rr[0]) + __uint_as_float(rr[1]); }
__device__ __forceinline__ float swap_max(float v) { auto rr = __builtin_amdgcn_permlane32_swap(__float_as_uint(v), __float_as_uint(v), false, false); return fmaxf(__uint_as_float(rr[0]), __uint_as_float(rr[1])); }
__device__ __forceinline__ float swap_other(float v, int hi) { auto rr = __builtin_amdgcn_permlane32_swap(__float_as_uint(v), __float_as_uint(v), false, false); return __uint_as_float(hi ? rr[0] : rr[1]); }
__device__ __forceinline__ void qkt(f32x16& p0, f32x16& p1, const LAS char* Ks, const bf16x8* qr, int r32, int hi) {
    p0 = f32x16{}; p1 = f32x16{};
#pragma unroll
    for (int d0 = 0; d0 < 8; ++d0) { const int cb = (d0 * 16 + hi * 8) * 2;
        const bf16x8 b0 = *(const LAS bf16x8*)(Ks + KSWZ(r32, cb)); const bf16x8 b1 = *(const LAS bf16x8*)(Ks + KSWZ(32 + r32, cb));
        p0 = __builtin_amdgcn_mfma_f32_32x32x16_bf16(b0, qr[d0], p0, 0, 0, 0);
        p1 = __builtin_amdgcn_mfma_f32_32x32x16_bf16(b1, qr[d0], p1, 0, 0, 0); }
}
__device__ __forceinline__ void qkt_l(f32x16& p0, f32x16& p1, const LAS char* Ks, const LAS char* Qs, int r32, int hi) {
    p0 = f32x16{}; p1 = f32x16{};
#pragma unroll
    for (int d0 = 0; d0 < 8; ++d0) { const int cb = (d0 * 16 + hi * 8) * 2;
        const bf16x8 b0 = *(const LAS bf16x8*)(Ks + KSWZ(r32, cb)); const bf16x8 b1 = *(const LAS bf16x8*)(Ks + KSWZ(32 + r32, cb)); const bf16x8 q = *(const LAS bf16x8*)(Qs + d0 * 1024);
        p0 = __builtin_amdgcn_mfma_f32_32x32x16_bf16(b0, q, p0, 0, 0, 0);
        p1 = __builtin_amdgcn_mfma_f32_32x32x16_bf16(b1, q, p1, 0, 0, 0); }
}
__device__ __forceinline__ void qkt32(f32x16& p0, const LAS char* Ks, const bf16x8* qr, int r32, int hi) {
    p0 = f32x16{};
#pragma unroll
    for (int d0 = 0; d0 < 8; ++d0) { const int cb = (d0 * 16 + hi * 8) * 2;
        const bf16x8 b0 = *(const LAS bf16x8*)(Ks + KSWZ(r32, cb)); p0 = __builtin_amdgcn_mfma_f32_32x32x16_bf16(b0, qr[d0], p0, 0, 0, 0); }
}
__device__ __forceinline__ int v_st(int k, int c) { const int kk = (k & ~0xC) | ((k & 4) << 1) | ((k & 8) >> 1); return ((kk >> 3) * 4 + (c >> 5)) * 512 + ((kk & 7) * 32 + (c & 31)) * 2; }
__device__ __forceinline__ int v_rd_base(int lane) { return ((lane & 3) << 3) | (((lane >> 2) & 3) << 6) | (((lane >> 4) & 1) << 5) | (((lane >> 5) & 1) << 8); }
constexpr int v_rd_off(int d0, int ks, int half) { return d0 * 512 + ks * 4096 + half * 2048; }
template <int OFF> __device__ __forceinline__ s16x4 tr_read(int vb) { s16x4 r; asm volatile("ds_read_b64_tr_b16 %0, %1 offset:%2" : "=&v"(r) : "v"(vb), "i"(OFF) : "memory"); return r; }
template <int D0> __device__ __forceinline__ void pv_one(f32x16& od, int vb, bf16x8 pa0, bf16x8 pa1, bf16x8 pa2, bf16x8 pa3) {
    const s16x4 l0 = tr_read<v_rd_off(D0, 0, 0)>(vb), h0 = tr_read<v_rd_off(D0, 0, 1)>(vb), l1 = tr_read<v_rd_off(D0, 1, 0)>(vb), h1 = tr_read<v_rd_off(D0, 1, 1)>(vb);
    const s16x4 l2 = tr_read<v_rd_off(D0, 2, 0)>(vb), h2 = tr_read<v_rd_off(D0, 2, 1)>(vb), l3 = tr_read<v_rd_off(D0, 3, 0)>(vb), h3 = tr_read<v_rd_off(D0, 3, 1)>(vb);
    asm volatile("s_waitcnt lgkmcnt(0)" ::: "memory"); SBAR();
#define PK(Lo, Hi) (bf16x8){Lo[0], Lo[1], Lo[2], Lo[3], Hi[0], Hi[1], Hi[2], Hi[3]}
    od = __builtin_amdgcn_mfma_f32_32x32x16_bf16(pa0, PK(l0, h0), od, 0, 0, 0);
    od = __builtin_amdgcn_mfma_f32_32x32x16_bf16(pa1, PK(l1, h1), od, 0, 0, 0);
    od = __builtin_amdgcn_mfma_f32_32x32x16_bf16(pa2, PK(l2, h2), od, 0, 0, 0);
    od = __builtin_amdgcn_mfma_f32_32x32x16_bf16(pa3, PK(l3, h3), od, 0, 0, 0);
#undef PK
}
__device__ __forceinline__ void pv_d0(f32x16* o, int vb, bf16x8 pa0, bf16x8 pa1, bf16x8 pa2, bf16x8 pa3) {
    pv_one<0>(o[0], vb, pa0, pa1, pa2, pa3); pv_one<1>(o[1], vb, pa0, pa1, pa2, pa3); pv_one<2>(o[2], vb, pa0, pa1, pa2, pa3); pv_one<3>(o[3], vb, pa0, pa1, pa2, pa3);
}
__device__ __forceinline__ void pack_p(const f32x16& p0, const f32x16& p1, bf16x8& pa0, bf16x8& pa1, bf16x8& pa2, bf16x8& pa3) {
#define PK4(P, BASE, OUT) do { unsigned a0 = cvtpk(P[BASE + 0], P[BASE + 1]), a1 = cvtpk(P[BASE + 2], P[BASE + 3]);   \
    unsigned b0 = cvtpk(P[BASE + 4], P[BASE + 5]), b1 = cvtpk(P[BASE + 6], P[BASE + 7]);                              \
    auto r0 = __builtin_amdgcn_permlane32_swap(a0, b0, false, false); auto r1 = __builtin_amdgcn_permlane32_swap(a1, b1, false, false); \
    u32x4 w = {r0[0], r1[0], r0[1], r1[1]}; OUT = __builtin_bit_cast(bf16x8, w); } while (0)
    PK4(p0, 0, pa0); PK4(p0, 8, pa1); PK4(p1, 0, pa2); PK4(p1, 8, pa3);
#undef PK4
}
__device__ __forceinline__ void mask_neginf(f32x16& p0, f32x16& p1, int lim, int hi) {
#pragma unroll
    for (int r = 0; r < 16; ++r) { const int k = crow(r, hi); p0[r] = (k <= lim) ? p0[r] : -INFINITY; p1[r] = (k + 32 <= lim) ? p1[r] : -INFINITY; }
}
__device__ __forceinline__ void partialSM(f32x16& p0, f32x16& p1, float& m_reg, float& alpha, bool rowvalid) {
    float pmax = p0[0];
#pragma unroll
    for (int r = 1; r < 16; ++r) pmax = fmaxf(pmax, p0[r]);
#pragma unroll
    for (int r = 0; r < 16; ++r) pmax = fmaxf(pmax, p1[r]);
    pmax = swap_max(pmax); pmax = rowvalid ? pmax : -INFINITY;
    float mn;
    if (__builtin_expect(__all(pmax - m_reg <= THR / ATT_SCALE), 1)) { mn = m_reg; alpha = 1.f; }
    else { mn = fmaxf(m_reg, pmax); alpha = __builtin_amdgcn_exp2f((m_reg - mn) * C2); m_reg = mn; }
    const float mnC = rowvalid ? -mn * C2 : -INFINITY;
#pragma unroll
    for (int r = 0; r < 16; ++r) p0[r] = fmaf(p0[r], C2, mnC);
#pragma unroll
    for (int r = 0; r < 16; ++r) p1[r] = fmaf(p1[r], C2, mnC);
#pragma unroll
    for (int r = 0; r < 16; ++r) p0[r] = __builtin_amdgcn_exp2f(p0[r]);
}
__device__ __forceinline__ void finishSM(f32x16& p0, f32x16& p1, float alpha, float& l_reg, bf16x8& pa0, bf16x8& pa1, bf16x8& pa2, bf16x8& pa3) {
#pragma unroll
    for (int r = 0; r < 16; ++r) p1[r] = __builtin_amdgcn_exp2f(p1[r]);
    float ps = 0.f;
#pragma unroll
    for (int r = 0; r < 16; ++r) ps += p0[r];
#pragma unroll
    for (int r = 0; r < 16; ++r) ps += p1[r];
    ps = swap_sum(ps);
    l_reg = l_reg * alpha + ps;
    pack_p(p0, p1, pa0, pa1, pa2, pa3);
}
template <bool MASK> __device__ __forceinline__ void sb_part1(f32x16& p0, f32x16& p1, float (&S)[8], int lim, int hi) {
#pragma unroll
    for (int g = 0; g < 8; ++g) { float ls[4], lk[4];
#pragma unroll
        for (int i = 0; i < 4; ++i) { const int r = 4 * (g & 3) + i; const float s = (g < 4) ? p0[r] : p1[r];
            const float z2 = s * C2; const float t2 = __builtin_amdgcn_logf(1.0f + __builtin_amdgcn_exp2f(-fabsf(z2)));
            float a = fminf(z2, 0.f) - t2, b = a - z2;
            if (MASK) { const bool keep = (8 * g + 4 * hi + i) <= lim; a = keep ? a : -INFINITY; b = keep ? b : 0.f; }
            ls[i] = a; lk[i] = b; }
        const float s2 = lk[3], s1 = s2 + lk[2], s0 = s1 + lk[1]; S[g] = s0 + lk[0];
        const float e0 = ls[0] + s0, e1 = ls[1] + s1, e2 = ls[2] + s2, e3 = ls[3];
        if (g < 4) { p0[4 * g] = e0; p0[4 * g + 1] = e1; p0[4 * g + 2] = e2; p0[4 * g + 3] = e3; } else { p1[4 * (g - 4)] = e0; p1[4 * (g - 4) + 1] = e1; p1[4 * (g - 4) + 2] = e2; p1[4 * (g - 4) + 3] = e3; } }
}
__device__ __forceinline__ void sb_part2(f32x16& p0, f32x16& p1, const float (&S)[8], float& carry, int hi, bf16x8& pa0, bf16x8& pa1, bf16x8& pa2, bf16x8& pa3) {
    float U[8], T[8];
#pragma unroll
    for (int g = 0; g < 8; ++g) { auto rr = __builtin_amdgcn_permlane32_swap(__float_as_uint(S[g]), __float_as_uint(S[g]), false, false);
        const float x0 = __uint_as_float(rr[0]), x1 = __uint_as_float(rr[1]); U[g] = x0 + x1; T[g] = hi ? x0 : x1; }
    float W = 0.f;
#pragma unroll
    for (int g = 7; g >= 0; --g) { const float base = carry + W + (hi ? 0.f : T[g]);
#pragma unroll
        for (int i = 0; i < 4; ++i) { if (g < 4) p0[4 * g + i] = __builtin_amdgcn_exp2f(p0[4 * g + i] + base); else p1[4 * (g - 4) + i] = __builtin_amdgcn_exp2f(p1[4 * (g - 4) + i] + base); }
        W += U[g]; }
    carry += W;
    pack_p(p0, p1, pa0, pa1, pa2, pa3);
}

__device__ __forceinline__ void store_o_tile(const f32x16* o, const float* sc16, const bf16* Zp, bf16* Op, size_t gbase  , LAS char* lds, int wid, int lane, int r32, int hi) {
    LAS float* ost = (LAS float*)(lds + wid * (32 * 68 * 4)); const int row = lane >> 1, half = lane & 1;
#pragma unroll
    for (int p = 0; p < 2; ++p) {
#pragma unroll
        for (int dd = 0; dd < 2; ++dd)
#pragma unroll
            for (int r = 0; r < 16; ++r) ost[crow(r, hi) * 68 + 32 * dd + r32] = o[2 * p + dd][r] * sc16[r];
        asm volatile("s_waitcnt lgkmcnt(0)" ::: "memory");
        f32x4 v[8];
#pragma unroll
        for (int c = 0; c < 8; ++c) v[c] = *(const LAS f32x4*)(ost + row * 68 + half * 32 + 4 * c);
        const size_t ga = gbase + (size_t)row * BW + 64 * p + 32 * half;
        u32x4 zz[4];
#pragma unroll
        for (int c = 0; c < 4; ++c) zz[c] = *(const u32x4*)(Zp + ga + 8 * c);
        asm volatile("s_waitcnt lgkmcnt(0)" ::: "memory");
#pragma unroll
        for (int c = 0; c < 4; ++c) { float z[8]; unpack8(zz[c], z); const f32x4 a = v[2 * c], b = v[2 * c + 1]; u32x4 w;
            w.x = cvtpk(a[0] * z[0], a[1] * z[1]); w.y = cvtpk(a[2] * z[2], a[3] * z[3]); w.z = cvtpk(b[0] * z[4], b[1] * z[5]); w.w = cvtpk(b[2] * z[6], b[3] * z[7]);
            *(u32x4*)(Op + ga + 8 * c) = w; }
    }
}
struct MixTensors { const bf16* Q; const bf16* K; const bf16* V; const bf16* Z; bf16* O; };
template <int MODE>
__device__ __forceinline__ void mix_unit(const MixTensors& T, const bf16* KM, int b, int h, int qb, LAS char* lds, const int wave_s) {
    const int lane = mk_lane(), wid = wave_s, tid = wid * 64 + lane, r32 = lane & 31, hi = lane >> 5;
    LAS char* V_lds = lds + OFF_V; LAS char* K_lds = lds + OFF_K; LAS float* wsl = (LAS float*)(lds + OFF_WS) + wid * 64;
    const size_t rowbase = (size_t)b * SEQ; const int i0 = qb * 256, qrow = i0 + wid * 32 + r32;
    const bf16* Kh = T.K + rowbase * BW + h * HD; const bf16* Vh = T.V + rowbase * BW + h * HD;
    bf16x8 qr[8];
    { const bf16* Qw = T.Q + (rowbase + qrow) * BW + h * HD + hi * 8;
#pragma unroll
      for (int d0 = 0; d0 < 8; ++d0) qr[d0] = *(const bf16x8*)(Qw + d0 * 16); }
    const int sr = tid >> 4, sc = (tid & 15) * 8, vst0 = v_st(sr, sc), vst1 = v_st(32 + sr, sc);
    const int vb0 = (int)(unsigned)(uintptr_t)V_lds + v_rd_base(lane);
    const LAS char* Qs = lds + OFF_Q + wid * 8192 + lane * 16;
    if (ATT_QLDS) {
#pragma unroll
        for (int d0 = 0; d0 < 8; ++d0) *(LAS bf16x8*)(lds + OFF_Q + wid * 8192 + d0 * 1024 + lane * 16) = qr[d0]; }
#define QKT(P0, P1, KS) do { if (ATT_QLDS) qkt_l(P0, P1, KS, Qs, r32, hi); else qkt(P0, P1, KS, qr, r32, hi); } while (0)
    unsigned sel = 0;
    if (MODE == 0) {
        *(LAS bf16x8*)(lds + OFF_G + KSWZ(sr, sc * 2)) = *(const bf16x8*)(KM + (size_t)sr * HD + sc);
        __syncthreads();
        f32x16 gp; qkt32(gp, lds + OFF_G, qr, r32, hi);
        float g[16];
#pragma unroll
        for (int r = 0; r < 8; ++r) { const float own = gp[r] + gp[r + 8]; const float oth = swap_other(own, hi); const int jb = (r & 3) + 8 * (r >> 2);
            g[jb] = hi ? oth : own; g[jb + 4] = hi ? own : oth; }
#pragma unroll
        for (int j = 0; j < 16; ++j) g[j] = (j < qb) ? g[j] : -INFINITY;
#pragma unroll
        for (int pass = 0; pass < 3; ++pass) { float mx = g[0];
#pragma unroll
            for (int j = 1; j < 16; ++j) mx = fmaxf(mx, g[j]);
            int idx = 16;
#pragma unroll
            for (int j = 15; j >= 0; --j) idx = (g[j] == mx) ? j : idx;
            if (mx > -INFINITY) sel |= 1u << idx;
#pragma unroll
            for (int j = 0; j < 16; ++j) g[j] = (j == idx) ? -INFINITY : g[j]; }
    }
    constexpr int SD = MODE == 0 ? ATT_SD_MOBA : ATT_SD_SB, SE = 0, SO = SD - 1;
    struct { bf16x8 vs0, vs1, ks0, ks1; } st_[SD];
#define SLOAD(i, k0) do { st_[i].vs0 = *(const bf16x8*)(Vh + (size_t)((k0) + sr) * BW + sc); st_[i].vs1 = *(const bf16x8*)(Vh + (size_t)((k0) + 32 + sr) * BW + sc); \
    st_[i].ks0 = *(const bf16x8*)(Kh + (size_t)((k0) + sr) * BW + sc); st_[i].ks1 = *(const bf16x8*)(Kh + (size_t)((k0) + 32 + sr) * BW + sc); } while (0)
#define SWRITE(bf, i) do { *(LAS bf16x8*)(V_lds + (bf) * SHM_V + vst0) = st_[i].vs0; *(LAS bf16x8*)(V_lds + (bf) * SHM_V + vst1) = st_[i].vs1; \
    *(LAS bf16x8*)(K_lds + (bf) * SHM_K + KSWZ(sr, sc * 2)) = st_[i].ks0; *(LAS bf16x8*)(K_lds + (bf) * SHM_K + KSWZ(32 + sr, sc * 2)) = st_[i].ks1; } while (0)
#define SWAIT() do { if (SD == 2) asm volatile("s_waitcnt vmcnt(4)" ::: "memory"); else asm volatile("s_waitcnt vmcnt(0)" ::: "memory"); } while (0)
    const int NT = 4 * (qb + 1);
#define KEY0(j) (64 * (j))
    float m_reg = -1e30f, l_reg = 0.f, carry = 0.f; f32x16 o[4] = {};
    f32x16 pA0, pA1, pB0, pB1; float alA = 1.f, alB = 1.f, SA[8], SB[8]; bf16x8 pa0, pa1, pa2, pa3;
#define STEP1(P0, P1, AL, SS, j) do { const int key0 = KEY0(j); \
        if (MODE == 0) { bool rv = true; if (key0 >= i0) mask_neginf(P0, P1, qrow - key0, hi); else rv = (sel >> (key0 >> 8)) & 1u; partialSM(P0, P1, m_reg, AL, rv); } \
        else { if (key0 >= i0) sb_part1<true>(P0, P1, SS, qrow - key0 - 1, hi); else sb_part1<false>(P0, P1, SS, 0, hi); } } while (0)
#define STEP2(P0, P1, AL, SS) do { if (MODE == 0) finishSM(P0, P1, AL, l_reg, pa0, pa1, pa2, pa3); else sb_part2(P0, P1, SS, carry, hi, pa0, pa1, pa2, pa3); } while (0)
#define RESC(a) do { if (MODE == 0) { if (__any((a) < 1.f)) { if (hi == 0) wsl[32 + r32] = (a); asm volatile("s_waitcnt lgkmcnt(0)" ::: "memory"); \
        _Pragma("unroll") for (int d = 0; d < 4; ++d) _Pragma("unroll") for (int r = 0; r < 16; ++r) o[d][r] *= wsl[32 + crow(r, hi)]; } } } while (0)
    SLOAD(SE, KEY0(0)); asm volatile("s_waitcnt vmcnt(0)" ::: "memory"); SWRITE(0, SE); __syncthreads();
    QKT(pA0, pA1, K_lds); STEP1(pA0, pA1, alA, SA, 0);
    SLOAD(SO, KEY0(1)); if (SD == 2) SLOAD(SE, KEY0(2));
    SWAIT(); SWRITE(1, SO); __syncthreads();
    for (int j = 1; j + 1 < NT; j += 2) {
        SBAR(); QKT(pB0, pB1, K_lds + SHM_K);
        STEP2(pA0, pA1, alA, SA); SBAR();
        SLOAD(SO, KEY0(j + SD)); SBAR();
        pv_d0(o, vb0, pa0, pa1, pa2, pa3); STEP1(pB0, pB1, alB, SB, j);
        __syncthreads(); SWAIT(); SWRITE(0, SE);
        RESC(alB); __syncthreads();
        SBAR(); QKT(pA0, pA1, K_lds);
        STEP2(pB0, pB1, alB, SB); SBAR();
        SLOAD(SE, KEY0(j + 1 + SD < NT ? j + 1 + SD : j)); SBAR();
        pv_d0(o, vb0 + SHM_V, pa0, pa1, pa2, pa3); STEP1(pA0, pA1, alA, SA, j + 1);
        __syncthreads(); SWAIT(); SWRITE(1, SO);
        RESC(alA); __syncthreads();
    }
    SBAR(); QKT(pB0, pB1, K_lds + SHM_K);
    STEP2(pA0, pA1, alA, SA); SBAR();
    pv_d0(o, vb0, pa0, pa1, pa2, pa3); STEP1(pB0, pB1, alB, SB, NT - 1);
    __syncthreads(); RESC(alB);
    STEP2(pB0, pB1, alB, SB); SBAR();
    pv_d0(o, vb0 + SHM_V, pa0, pa1, pa2, pa3);
    asm volatile("s_waitcnt vmcnt(0)" ::: "memory");
    float rli[16];
    if (MODE == 0) { if (hi == 0) wsl[r32] = l_reg; asm volatile("s_waitcnt lgkmcnt(0)" ::: "memory");
#pragma unroll
        for (int r = 0; r < 16; ++r) rli[r] = __builtin_amdgcn_rcpf(wsl[crow(r, hi)]); }
    else {
#pragma unroll
        for (int r = 0; r < 16; ++r) rli[r] = 1.f; }
    __syncthreads();
    store_o_tile(o, rli, T.Z, T.O, (rowbase + i0 + wid * 32) * BW + h * HD, lds, wid, lane, r32, hi);
    __syncthreads();
#undef SLOAD
#undef SWRITE
#undef SWAIT
#undef KEY0
#undef STEP1
#undef STEP2
#undef RESC
#undef QKT
}

__device__ __forceinline__ void sb_unit(const MixTensors& T, int b, int h, int qb, LAS char* lds, const int wave_s) {
    const int lane = mk_lane(), wid = wave_s, tid = wid * 64 + lane, r32 = lane & 31, hi = lane >> 5;
    LAS char* V_lds = lds + OFF_V; LAS char* K_lds = lds + OFF_K; LAS int* dn = (LAS int*)(lds + OFF_WS);
    const size_t rowbase = (size_t)b * SEQ; const int i0 = qb * 256, qrow = i0 + wid * 32 + r32;
    const bf16* Kh = T.K + rowbase * BW + h * HD; const bf16* Vh = T.V + rowbase * BW + h * HD;
    bf16x8 qr[8];
    { const bf16* Qw = T.Q + (rowbase + qrow) * BW + h * HD + hi * 8;
#pragma unroll
      for (int d0 = 0; d0 < 8; ++d0) qr[d0] = *(const bf16x8*)(Qw + d0 * 16); }
    const int sr = tid >> 4, sc = (tid & 15) * 8, vst0 = v_st(sr, sc), vst1 = v_st(32 + sr, sc);
    const int vb0 = (int)(unsigned)(uintptr_t)V_lds + v_rd_base(lane);
    if (tid < 16) dn[tid] = 0;
    bf16x8 vs0, vs1, ks0, ks1;
#define SLOAD(k0) do { vs0 = *(const bf16x8*)(Vh + (size_t)((k0) + sr) * BW + sc); vs1 = *(const bf16x8*)(Vh + (size_t)((k0) + 32 + sr) * BW + sc); \
    ks0 = *(const bf16x8*)(Kh + (size_t)((k0) + sr) * BW + sc); ks1 = *(const bf16x8*)(Kh + (size_t)((k0) + 32 + sr) * BW + sc); } while (0)
#define SWRITE(bf) do { *(LAS bf16x8*)(V_lds + (bf) * SHM_V + vst0) = vs0; *(LAS bf16x8*)(V_lds + (bf) * SHM_V + vst1) = vs1; \
    *(LAS bf16x8*)(K_lds + (bf) * SHM_K + KSWZ(sr, sc * 2)) = ks0; *(LAS bf16x8*)(K_lds + (bf) * SHM_K + KSWZ(32 + sr, sc * 2)) = ks1; } while (0)
    const int NT = 4 * (qb + 1);
    float carry = 0.f; f32x16 o[4] = {}; bool wdone = false;
    SLOAD(64 * (NT - 1)); SWRITE(0); __syncthreads();
    for (int j = 0; j < NT; ++j) {
        const int bf = j & 1, key0 = 64 * (NT - 1 - j);
        if (j + 1 < NT) SLOAD(key0 - 64);
        if (!wdone && key0 < i0 + wid * 32 + 32) {
            f32x16 p0, p1; float S[8]; bf16x8 pa0, pa1, pa2, pa3;
            qkt(p0, p1, K_lds + bf * SHM_K, qr, r32, hi);
            if (key0 + 63 >= i0 + wid * 32) sb_part1<true>(p0, p1, S, qrow - key0 - 1, hi); else sb_part1<false>(p0, p1, S, 0, hi);
            sb_part2(p0, p1, S, carry, hi, pa0, pa1, pa2, pa3);
            pv_d0(o, vb0 + bf * SHM_V, pa0, pa1, pa2, pa3);
            wdone = __all(carry < -160.f);
        }
        if (lane == 0) dn[bf * 8 + wid] = wdone ? 1 : 0;
        if (j + 1 < NT) SWRITE(bf ^ 1);
        __syncthreads();
        if (__all(dn[bf * 8 + (lane & 7)] != 0)) break;
    }
    { float one16[16];
#pragma unroll
      for (int r = 0; r < 16; ++r) one16[r] = 1.f;
      store_o_tile(o, one16, T.Z, T.O, (rowbase + i0 + wid * 32) * BW + h * HD, lds, wid, lane, r32, hi); }
    __syncthreads();
#undef SLOAD
#undef SWRITE
}
#undef KSWZ
#undef SBAR
}

__device__ __forceinline__ void group_barrier(gu32* cnt, int local, unsigned* bar, int wave) {
    asm volatile("s_waitcnt vmcnt(0)" ::: "memory");
    __syncthreads();
    if (wave == 0) { if (mk_lane() == 0) {
        if (!local) { __builtin_amdgcn_fence(__ATOMIC_RELEASE, "agent"); asm volatile("s_waitcnt vmcnt(0)" ::: "memory"); }
        (void)xb_add((unsigned*)cnt, 1u);
        XB_SPIN(xb_ld((unsigned*)cnt) < 8u, bar);
        __builtin_amdgcn_fence(__ATOMIC_ACQUIRE, "agent"); asm volatile("s_waitcnt vmcnt(0)" ::: "memory"); } }
    __syncthreads();
}
struct Args { const float* in[10]; float* out; unsigned char* ws; int ph_lo, ph_hi; };
__global__ void __launch_bounds__(NWAVES * 64, 2) mk_fwd(Args args) {
    extern __shared__ __attribute__((aligned(16))) unsigned char lds[];
    LAS unsigned char* L = (LAS unsigned char*)lds;
    volatile LAS unsigned* MISC = (volatile LAS unsigned*)(L + MISC_OFF);
    const int wave_s = __builtin_amdgcn_readfirstlane(threadIdx.x >> 6);
    const int G = gridDim.x, NGW = G * NWAVES; const size_t NGT = (size_t)G * NWAVES * 64;
#define PHASE_IDS() const int lane = mk_lane(), wave = wave_s, tid = wave * 64 + lane, gw = blockIdx.x * NWAVES + wave; const size_t gt = (size_t)blockIdx.x * (NWAVES * 64) + tid; (void)lane; (void)gw; (void)gt
    unsigned char* ws = args.ws; gu32* ctl = (gu32*)(ws + WS_CTL);
    const float* x = args.in[0]; const float* pre_g = args.in[1]; const float* post_g = args.in[2]; const float* w_in = args.in[3]; const float* b_merge = args.in[4];
    const float* conv_w = args.in[5]; const float* w_out = args.in[9]; float* out = args.out;
    float2* rope = (float2*)(ws + WS_ROPE); bf16* KM = (bf16*)(ws + WS_KM); bf16* H = (bf16*)(ws + WS_H); bf16* T = (bf16*)(ws + WS_T); bf16* OBR = (bf16*)(ws + WS_OBR);
    bf16* Y = (bf16*)(ws + WS_Y); bf16* OUTB = (bf16*)(ws + WS_OUT); unsigned char* H8 = ws + WS_H8; float* SBv = (float*)(ws + WS_KMEAN); float* SAv = SBv + NGATE + INC; float* SBO = SAv + M; float* SAY = SBO + DM; unsigned char* Y8 = ws + WS_Y8;
    for (int u = threadIdx.x; u < (LDS_BYTES - RING_BYTES) / 4; u += NWAVES * 64) ((LAS unsigned*)(L + RING_BYTES))[u] = 0u;
    __syncthreads();
    XcdBarrier bar; bar.bar = (unsigned*)(ctl + CW_BAR); bar.x = 0; bar.st = nullptr; bar.expect = 0u;
    if (!MK_PER_PHASE) bar = xcd_barrier_post((unsigned*)(ctl + CW_BAR), MISC + 8);
    XcdBarrier barh = bar;
    if (!MK_PER_PHASE && gridDim.x == 256) barh = xcd_barrier_post((unsigned*)(ctl + CW_BARH + (((int)blockIdx.x & 7) >> 2) * 4096), MISC + 10, 128u);
    if (threadIdx.x == 0) __hip_atomic_store(ctl + CW_XID + blockIdx.x, xb_xcc_id() + 1u, RLX_AGENT);
#define GRID_BAR(seam) do { if (MK_PER_PHASE) { if (threadIdx.x == 0) __hip_atomic_store(ctl + CW_TMO, 0xBADBA0u | (unsigned)(seam), RLX_AGENT); } else { xcd_barrier(bar); } } while (0)
    const int lo = args.ph_lo, hi = args.ph_hi;
#define IN(k) (lo <= (k) && (k) < hi)
#define BOTH(k) (IN(k) && IN((k) + 1))

    if (IN(0)) { PHASE_IDS();
        LAS float* scr = (LAS float*)(L + wave * 16384);
        constexpr int I_IN = (DM / 64) * (NPROJ / 32), I_BR = (BW / 64) * (DM / 32), I_O = (DM / 64) * (DM / 32), I_L = 3 * I_BR, NB8 = NGATE / 32, NBA = INC / 32, NBO = DM / 32;
        for (;;) { LAS int* clm = (LAS int*)(L + 13312);
            if (tid == 0) *clm = (int)__hip_atomic_fetch_add(ctl + CW_QCLAIM, 1u, RLX_AGENT);
            __syncthreads(); const int cb = *clm; if (cb >= NB8 + NBA + NBO) break;
            if (cb < NB8) { const int n0 = 32 * cb, ns = n0 < 4 * BW ? n0 : n0 + 4 * BW;
                const int r8 = (NGATE / 256 - 1 - (n0 >> 8)) * 256 + (n0 & 255);
                quant_block(w_in, INC, ns, ws + WS_WIN + W8_OFF + (size_t)r8 * DM, SBv + r8, L, wave, lane); }
            else if (cb < NB8 + NBA) { const int n0 = 32 * (cb - NB8), nd = remap_conv_col(n0);
                const int o8 = nd >> 8, r8 = (o8 < 32 ? o8 + 112 : (o8 < 96 ? o8 + 16 : o8 - 96)) * 256 + (nd & 255);
                quant_block(w_in + (size_t)DM * INC, INC, n0, ws + WS_WIN + WIN_BYTES + W8_OFF + (size_t)r8 * DM, SBv + NGATE + r8, L, wave, lane); }
            else { const int n0 = 32 * (cb - NB8 - NBA);
                quant_block(w_out + (size_t)DM * DM, DM, n0, ws + WS_WO + WO_BYTES + (size_t)n0 * DM, SBO + n0, L, wave, lane); } }
        for (;;) { int c0 = 0; if (lane == 0) c0 = (int)__hip_atomic_fetch_add(ctl + CW_QCLAIM + 1, 1u, RLX_AGENT);
          c0 = __builtin_amdgcn_readfirstlane(c0) * 16; if (c0 >= I_IN + I_O + DEPTH * I_L) break;
          for (int it = c0; it < c0 + 16; ++it) {
            if (it < I_IN) { transpose_item<true>(w_in, DM, INC, (bf16*)(ws + WS_WIN), scr, (it / (NPROJ / 32)) * (INC / 32) + (4 * BW / 32) + it % (NPROJ / 32), lane); continue; }
            if (it < I_IN + I_O) { transpose_item(w_out, DM, DM, (bf16*)(ws + WS_WO), scr, it - I_IN, lane); continue; }
            const int Lr = (it - I_IN - I_O) / I_L, r = (it - I_IN - I_O) - Lr * I_L, i = r / I_BR;
            transpose_item((i == 0 ? args.in[6] : (i == 1 ? args.in[7] : args.in[8])) + (size_t)Lr * BW * DM, BW, DM, (bf16*)(ws + WS_WBR + Lr * WBR_BYTES) + (size_t)i * DM * BW, scr, r - i * I_BR, lane); } }
        for (size_t i = gt; i < (size_t)SEQ * 16; i += NGT) rope_entry(rope, (int)i);
        for (;;) { int m0 = 0; if (lane == 0) m0 = (int)__hip_atomic_fetch_add(ctl + CW_QCLAIM + 3, 1u, RLX_AGENT);
            m0 = __builtin_amdgcn_readfirstlane(m0) * 2; if (m0 >= M) break;
            for (int m = m0; m < m0 + 2; ++m) rmsnorm_row_bf16(x + (size_t)m * DM, pre_g, H + (size_t)m * DM, H8 + (size_t)m * DM, SAv + m, lane); }
        if (BOTH(0)) GRID_BAR(0);
    }
    int grp = 0, grp_local = 0; const int gpm = 4 * ((int)blockIdx.x & 7) + (((int)blockIdx.x >> 3) & 3), gmi = (int)blockIdx.x >> 5;
    if (!MK_PER_PHASE && G == 256) { const unsigned my = xb_ld((unsigned*)(ctl + CW_XID + blockIdx.x)); int same = 1;
#pragma unroll
        for (int q = 0; q < 8; ++q) same &= (xb_ld((unsigned*)(ctl + CW_XID + (blockIdx.x & 7) + 8 * (((blockIdx.x >> 3) & 3) + 4 * q))) == my) ? 1 : 0;
        grp = 1; grp_local = __builtin_amdgcn_readfirstlane(same); }
#define SEAM_BAR(gs_, seam_) do { if (grp) group_barrier(ctl + CW_GRP + ((gs_) * 32 + gpm) * 8, grp_local, (unsigned*)(ctl + CW_BAR), wave_s); else GRID_BAR(seam_); } while (0)
#define MY_ROWS(m_, ...) do { if (grp) { for (int i_ = 0; i_ < 4; ++i_) { const int m_ = 256 * gpm + 32 * gmi + 4 * wave + i_; __VA_ARGS__; } } else { for (int m_ = gw; m_ < M; m_ += NGW) { __VA_ARGS__; } } } while (0)
    for (int Lr = 0; Lr < DEPTH; ++Lr) {
        const int pb = 1 + Lr * PH_PER_LAYER; const float* xc = Lr == 0 ? x : out;
        if (IN(pb + 0)) {
            if (Lr == 0) { pg8::Gemm g{H, (const bf16*)(ws + WS_WIN) + (size_t)4 * BW * DM, M, NPROJ, DM, 0}; pg8::StaticOrder S; S.init(M, NPROJ, G, (int)blockIdx.x);
              pg8::EpiProjT<false> E{T, (const float*)rope, b_merge, SAv, SBv, 0};
              pg8::gemm_phase<pg8::EpiProjT<false>, pg8::StaticOrder, true, true>(L, g, S, E, wave_s); }
            { const int N8 = Lr == 0 ? NGATE : INC;
              pg8::Gemm g{(const bf16*)H8, (const bf16*)(ws + WS_WIN + Lr * WIN_BYTES + W8_OFF), M, N8, DM / 2, 0}; pg8::ProjOrder S; S.init(M, N8, G, (int)blockIdx.x, T + TE, KM, (LAS float*)(L + RING_BYTES), Lr != 0, wave_s);
              pg8::EpiProjT<true> E{T, (const float*)rope, b_merge + Lr * 3 * DM, SAv, SBv + Lr * NGATE, Lr != 0};
              pg8::gemm_phase<pg8::EpiProjT<true>, pg8::ProjOrder, true, true, true>(L, g, S, E, wave_s); }
            if (BOTH(pb + 0)) { if (grp) xcd_barrier(barh); else GRID_BAR(pb + 0); }
        }
        if (IN(pb + 2)) {
            { const att::MixTensors TA{T + 0 * TE, T + 1 * TE, T + 2 * TE, T + 3 * TE, OBR + 0 * TE};
              for (int pi = blockIdx.x; pi < 256; pi += G) { const int bh = 4 * (pi & 7) + (pi >> 6), pr = (pi >> 3) & 7;
                  for (int u = 0; u < 2; ++u) att::mix_unit<0>(TA, KM + (size_t)bh * 32 * HD, bh >> 4, bh & 15, u ? pr : 15 - pr, (LAS char*)L, wave_s); } }
            { const att::MixTensors TC{T + 8 * TE, T + 9 * TE, T + 10 * TE, T + 11 * TE, OBR + 2 * TE};
              for (int pi = blockIdx.x; pi < 256; pi += G) { const int bh = 4 * (pi & 7) + (pi >> 6), pr = (pi >> 3) & 7;
                  for (int u = 0; u < 2; ++u) att::sb_unit(TC, bh >> 4, bh & 15, u ? pr : 15 - pr, (LAS char*)L, wave_s); } }
            { PHASE_IDS();
            const float* cw = conv_w + Lr * 3 * BW;
            for (int rb0 = blockIdx.x; rb0 < M / 32; rb0 += G) { const int rb = grp ? gpm * 8 + gmi : rb0;
                const int R0 = rb * 32 + (tid >> 8) * 16, c = (tid & 255) * 8, t0 = R0 & (SEQ - 1);
                const f32x4 wa0 = *(const f32x4*)(cw + c), wa1 = *(const f32x4*)(cw + c + 4), wb0 = *(const f32x4*)(cw + BW + c), wb1 = *(const f32x4*)(cw + BW + c + 4), wc0 = *(const f32x4*)(cw + 2 * BW + c), wc1 = *(const f32x4*)(cw + 2 * BW + c + 4);
                const size_t base = (size_t)R0 * BW + c; float x1[8], x2[8];
                if (t0 != 0) { ld8(T + 5 * TE + base - BW, x1); ld8(T + 5 * TE + base - 2 * BW, x2); }
                else {
#pragma unroll
                    for (int e = 0; e < 8; ++e) { x1[e] = 0.f; x2[e] = 0.f; } }
#pragma unroll
                for (int h = 0; h < 2; ++h) { u32x4 gv[8], xv[8];
#pragma unroll
                    for (int r = 0; r < 8; ++r) { gv[r] = *(const u32x4*)(T + 4 * TE + base + (size_t)(8 * h + r) * BW); xv[r] = *(const u32x4*)(T + 5 * TE + base + (size_t)(8 * h + r) * BW); }
#pragma unroll
                    for (int r = 0; r < 8; ++r) { float gb[8], x0[8], o[8]; unpack8(gv[r], gb); unpack8(xv[r], x0);
#pragma unroll
                        for (int e = 0; e < 8; ++e) { const float w0 = e < 4 ? wa0[e & 3] : wa1[e & 3], w1 = e < 4 ? wb0[e & 3] : wb1[e & 3], w2 = e < 4 ? wc0[e & 3] : wc1[e & 3];
                            o[e] = gb[e] * (w0 * x2[e] + w1 * x1[e] + w2 * x0[e]); x2[e] = x1[e]; x1[e] = x0[e]; }
                        u32x4 w; w.x = pk2(o[0], o[1]); w.y = pk2(o[2], o[3]); w.z = pk2(o[4], o[5]); w.w = pk2(o[6], o[7]); *(u32x4*)(OBR + 1 * TE + base + (size_t)(8 * h + r) * BW) = w; } } }
            }
            if (BOTH(pb + 2)) { if (grp) xcd_barrier(barh); else GRID_BAR(pb + 2); }
        }
        if (IN(pb + 3)) {
            pg8::Gemm g{OBR, (const bf16*)(ws + WS_WBR + Lr * WBR_BYTES), 3 * M, 3 * DM, BW, 0}; pg8::BranchOrder S; S.init(G, (int)blockIdx.x);
            pg8::EpiBranch E{T + 12 * TE, Y};
            pg8::gemm_phase<pg8::EpiBranch, pg8::BranchOrder, true, true>(L, g, S, E, wave_s);
            if (BOTH(pb + 3)) SEAM_BAR(3 * Lr + 0, pb + 3);
        }
        if (IN(pb + 4) && Lr == DEPTH - 1) { PHASE_IDS();
            MY_ROWS(m, yq_row(Y + (size_t)m * DM, Y8 + (size_t)m * DM, SAY + m, lane));
            if (BOTH(pb + 4)) SEAM_BAR(3 * Lr + 1, pb + 4);
        }
        if (IN(pb + 5)) {
            if (Lr < DEPTH - 1) { pg8::Gemm g{Y, (const bf16*)(ws + WS_WO + Lr * WO_BYTES), M, DM, DM, 0}; pg8::StaticOrder S; S.init(M, DM, G, (int)blockIdx.x);
                pg8::EpiBf16Plain E{OUTB, DM, 0};
                pg8::gemm_phase<pg8::EpiBf16Plain, pg8::StaticOrder, true, true>(L, g, S, E, wave_s); }
            else { pg8::Gemm g{(const bf16*)Y8, (const bf16*)(ws + WS_WO + Lr * WO_BYTES), M, DM, DM / 2, 0}; pg8::StaticOrder S; S.init(M, DM, G, (int)blockIdx.x);
                pg8::EpiOut8 E{OUTB, SAY, SBO};
                pg8::gemm_phase<pg8::EpiOut8, pg8::StaticOrder, true, true, true>(L, g, S, E, wave_s); }
            if (BOTH(pb + 5)) SEAM_BAR(Lr == 0 ? 1 : 5, pb + 5);
        }
        if (IN(pb + 6)) { PHASE_IDS();
            bf16* X1B = (bf16*)(ws + WS_X1);
            if (Lr + 1 < DEPTH) { MY_ROWS(m, final_row<false, true>(x + (size_t)m * DM, OUTB + (size_t)m * DM, post_g + Lr * DM, X1B + (size_t)m * DM, pre_g + (Lr + 1) * DM, (bf16*)nullptr  , H8 + (size_t)m * DM, SAv + m, lane)); }
            else { MY_ROWS(m, final_row<true, false>(X1B + (size_t)m * DM, OUTB + (size_t)m * DM, post_g + Lr * DM, out + (size_t)m * DM, nullptr, H + (size_t)m * DM, H8 + (size_t)m * DM, SAv + m, lane)); }
            if (BOTH(pb + 6)) SEAM_BAR(2, pb + 6);
        }
    }
#undef IN
#undef BOTH
}

extern "C" void kernel_launch(void* const* d_in, const int* in_sizes, int n_in, void* d_out, int out_size, void* d_ws, size_t ws_size, hipStream_t stream) {
    static int grid = 0;
    if (grid == 0) {
        if (n_in != 10 || in_sizes[0] != M * DM || out_size != M * DM || ws_size < WS_END) { fprintf(stderr, "kernel_launch: shape mismatch (n_in %d, in0 %d, out %d, ws %zu, need %zu)\n", n_in, n_in > 0 ? in_sizes[0] : -1, out_size, ws_size, (size_t)WS_END); grid = -1; return; }
        int dev = 0, cus = 0, per_cu = 0;
        if (hipGetDevice(&dev) != hipSuccess || hipDeviceGetAttribute(&cus, hipDeviceAttributeMultiprocessorCount, dev) != hipSuccess) { fprintf(stderr, "kernel_launch: device query failed\n"); grid = -1; return; }
        if (hipFuncSetAttribute((const void*)mk_fwd, hipFuncAttributeMaxDynamicSharedMemorySize, LDS_BYTES) != hipSuccess) { fprintf(stderr, "kernel_launch: hipFuncSetAttribute failed\n"); grid = -1; return; }
        if (hipOccupancyMaxActiveBlocksPerMultiprocessor(&per_cu, (const void*)mk_fwd, NWAVES * 64, LDS_BYTES) != hipSuccess || per_cu < 1) { fprintf(stderr, "kernel_launch: occupancy query says %d workgroups per CU\n", per_cu); }
        (void)hipGetLastError();
        grid = cus;
    }
    if (grid < 0) return;
    if (hipMemsetAsync((char*)d_ws + WS_CTL, 0, CTL_ZERO_BYTES, stream) != hipSuccess) { fprintf(stderr, "kernel_launch: memset failed\n"); return; }
    Args a{};
    for (int i = 0; i < 10; ++i) a.in[i] = (const float*)d_in[i];
    a.out = (float*)d_out; a.ws = (unsigned char*)d_ws;
#if MK_PER_PHASE
    for (int p = 0; p < N_PHASES; ++p) {
        a.ph_lo = p; a.ph_hi = p + 1; hipLaunchKernelGGL(mk_fwd, dim3(grid), dim3(NWAVES * 64), LDS_BYTES, stream, a); }
#else
    a.ph_lo = 0; a.ph_hi = N_PHASES; hipLaunchKernelGGL(mk_fwd, dim3(grid), dim3(NWAVES * 64), LDS_BYTES, stream, a);
#endif
    const hipError_t le = hipPeekAtLastError();
    if (le != hipSuccess) fprintf(stderr, "kernel_launch: launch failed: %s\n", hipGetErrorName(le));
}
```
